# Optimizing an MI355X kernel written in HIP

```python
import math
import jax, jax.numpy as jnp
from jax import lax
import numpy as np

D_MODEL = 1024
BATCH = 8
SEQ = 4096
DEPTH = 1

NORM_EPS = 1e-6
D_FF = 2816
GDN_HEADS = 4
GDN_HEAD_DIM = 128
GDN_WIDTH = GDN_HEADS * GDN_HEAD_DIM
GDN_CHUNK = 64
CONV_WIDTH = 4
MOBA_HEADS = 8
MOBA_HEAD_DIM = 64
MOBA_WIDTH = MOBA_HEADS * MOBA_HEAD_DIM
MOBA_BLOCK = 256
MOBA_TOPK = 3
MOBA_Q_CHUNK = 128
ROPE_THETA = 500000.0
ROPE_DIM = MOBA_HEAD_DIM // 4
MIX_WIDTH = GDN_WIDTH + MOBA_WIDTH
OFF_GDN_QKV = 3 * GDN_WIDTH
OFF_GDN_Z = 4 * GDN_WIDTH
OFF_GDN_A = OFF_GDN_Z + GDN_HEADS
OFF_GDN_B = OFF_GDN_A + GDN_HEADS
OFF_MOBA_Q = OFF_GDN_B + MOBA_WIDTH
OFF_MOBA_K = OFF_MOBA_Q + MOBA_WIDTH
IN_PROJ_DIM = OFF_MOBA_K + MOBA_WIDTH

kernel_name = "hymba_gdn_moba_macaron"


def rms_norm(x, g, eps=NORM_EPS):
    xf = x.astype(jnp.float32)
    y = xf * lax.rsqrt(jnp.mean(xf * xf, axis=-1, keepdims=True) + eps)
    return (y * g).astype(x.dtype)


def l2_normalize(x, eps=NORM_EPS):
    return x * lax.rsqrt(jnp.sum(x * x, axis=-1, keepdims=True) + eps)


def swiglu_ffn(x, norm_g, w_gate, w_up, w_down):
    h = rms_norm(x, norm_g)
    return (jax.nn.silu(h @ w_gate) * (h @ w_up)) @ w_down


def causal_dwconv(x, w):
    kw = w.shape[0]
    return lax.conv_general_dilated(
        x, w[:, None, :].astype(x.dtype), window_strides=(1,), padding=[(kw - 1, 0)],
        dimension_numbers=('NWC', 'WIO', 'NWC'), feature_group_count=x.shape[-1])


def partial_rope(x, pos):
    half = ROPE_DIM // 2
    inv_freq = jnp.power(jnp.float32(ROPE_THETA), -jnp.arange(half, dtype=jnp.float32) * 2.0 / ROPE_DIM)
    ang = pos.astype(jnp.float32)[:, None] * inv_freq[None, :]
    cos, sin = jnp.cos(ang)[:, None, :], jnp.sin(ang)[:, None, :]
    xr = x[..., :ROPE_DIM].astype(jnp.float32)
    x1, x2 = xr[..., :half], xr[..., half:]
    rot = jnp.concatenate([x1 * cos - x2 * sin, x2 * cos + x1 * sin], axis=-1)
    return jnp.concatenate([rot.astype(x.dtype), x[..., ROPE_DIM:]], axis=-1)


def gated_deltanet(q, k, v, z, a, b, a_log, dt_bias, out_gain):
    bsz, seq, _ = q.shape
    H, Dh, C = GDN_HEADS, GDN_HEAD_DIM, GDN_CHUNK
    n_chunks = seq // C
    f32 = jnp.float32
    q = l2_normalize(q.reshape(bsz, seq, H, Dh).astype(f32)) * (Dh ** -0.5)
    k = l2_normalize(k.reshape(bsz, seq, H, Dh).astype(f32))
    v = v.reshape(bsz, seq, H, Dh).astype(f32)
    beta = jax.nn.sigmoid(b.astype(f32))
    g = -jnp.exp(a_log.astype(f32)) * jax.nn.softplus(a.astype(f32) + dt_bias.astype(f32))

    def chunks(t):
        return t.reshape(bsz, n_chunks, C, H, -1).transpose(0, 3, 1, 2, 4)

    qc, kc, vc = chunks(q), chunks(k), chunks(v)
    beta_c = chunks(beta[..., None])[..., 0]
    gcum = jnp.cumsum(chunks(g[..., None])[..., 0], axis=-1)
    idx = jnp.arange(C)
    causal = idx[:, None] >= idx[None, :]
    strict = idx[:, None] > idx[None, :]
    decay = jnp.exp(jnp.where(causal, gcum[..., :, None] - gcum[..., None, :], -jnp.inf))
    k_beta = kc * beta_c[..., None]
    lower = jnp.where(strict, jnp.einsum('bhnid,bhnjd->bhnij', k_beta, kc) * decay, 0.0)
    rhs = jnp.concatenate([vc * beta_c[..., None], k_beta * jnp.exp(gcum)[..., None]], axis=-1)
    sol = lax.linalg.triangular_solve(jnp.eye(C, dtype=f32) + lower, rhs,
                                      left_side=True, lower=True, unit_diagonal=True)
    u, w = sol[..., :Dh], sol[..., Dh:]
    intra = jnp.einsum('bhnid,bhnjd->bhnij', qc, kc) * decay
    q_dec = qc * jnp.exp(gcum)[..., None]
    k_dec = kc * jnp.exp(gcum[..., -1:] - gcum)[..., None]
    g_last = jnp.exp(gcum[..., -1])
    xs = tuple(jnp.moveaxis(t, 2, 0) for t in (q_dec, k_dec, u, w, intra, g_last))

    def step(state, inp):
        q_i, k_i, u_i, w_i, a_i, gl_i = inp
        v_new = u_i - jnp.einsum('bhck,bhkv->bhcv', w_i, state)
        o_i = jnp.einsum('bhck,bhkv->bhcv', q_i, state) + jnp.einsum('bhij,bhjv->bhiv', a_i, v_new)
        state = state * gl_i[..., None, None] + jnp.einsum('bhck,bhcv->bhkv', k_i, v_new)
        return state, o_i

    _, o = lax.scan(step, jnp.zeros((bsz, H, Dh, Dh), f32), xs)
    o = o.transpose(1, 0, 3, 2, 4).reshape(bsz, seq, H, Dh)
    o = rms_norm(o, out_gain) * jax.nn.silu(z.reshape(bsz, seq, H, Dh).astype(f32))
    return o.reshape(bsz, seq, H * Dh).astype(z.dtype)


def moba_attention(q, k, v, q_gain, k_gain):
    bsz, seq, _ = q.shape
    H, D, BLK, QC = MOBA_HEADS, MOBA_HEAD_DIM, MOBA_BLOCK, MOBA_Q_CHUNK
    n_blocks = -(-seq // BLK)
    seq_p = n_blocks * BLK
    n_qc = seq_p // QC
    topk = min(MOBA_TOPK, n_blocks)
    scale = D ** -0.5
    pos = jnp.arange(seq)
    q = partial_rope(rms_norm(q.reshape(bsz, seq, H, D), q_gain), pos)
    k = partial_rope(rms_norm(k.reshape(bsz, seq, H, D), k_gain), pos)
    v = v.reshape(bsz, seq, H, D)
    pad = [(0, 0), (0, seq_p - seq), (0, 0), (0, 0)]
    q, k, v = (jnp.pad(t, pad).transpose(0, 2, 1, 3) for t in (q, k, v))
    kb = k.reshape(bsz, H, n_blocks, BLK, D)
    vb = v.reshape(bsz, H, n_blocks, BLK, D)
    k_mean = jnp.mean(kb.astype(jnp.float32), axis=3)
    gate = jnp.einsum('bhsd,bhnd->bhsn', q.astype(jnp.float32), k_mean)
    q_block = jnp.arange(seq_p) // BLK
    past = jnp.arange(n_blocks)[None, :] < q_block[:, None]
    gate = jnp.where(past, gate, -jnp.inf)
    _, sel = lax.top_k(gate, topk)

    q_ch = q.reshape(bsz, H, n_qc, QC, D).transpose(0, 2, 1, 3, 4).reshape(bsz * n_qc, H, QC, D)
    sel_ch = sel.reshape(bsz, H, n_qc, QC, topk).transpose(0, 2, 1, 3, 4).reshape(bsz * n_qc, H, QC, topk)
    b_idx = jnp.repeat(jnp.arange(bsz, dtype=jnp.int32), n_qc)
    c_idx = jnp.tile(jnp.arange(n_qc, dtype=jnp.int32), bsz)
    head_ix = jnp.arange(H)[:, None, None]

    def chunk_fn(args):
        qc, selc, bi, ci = args
        kb_b, vb_b = kb[bi], vb[bi]
        k_sel = kb_b[head_ix, selc]
        v_sel = vb_b[head_ix, selc]
        own = (ci * QC) // BLK
        k_own = lax.dynamic_index_in_dim(kb_b, own, axis=1, keepdims=False)
        v_own = lax.dynamic_index_in_dim(vb_b, own, axis=1, keepdims=False)
        valid = jnp.arange(topk) < own
        s_sel = jnp.einsum('hqd,hqtkd->hqtk', qc, k_sel).astype(jnp.float32) * scale
        s_sel = jnp.where(valid[None, None, :, None], s_sel, -jnp.inf)
        q_pos = ci * QC + jnp.arange(QC)
        k_pos = own * BLK + jnp.arange(BLK)
        s_own = jnp.einsum('hqd,hkd->hqk', qc, k_own).astype(jnp.float32) * scale
        s_own = jnp.where(k_pos[None, None, :] <= q_pos[None, :, None], s_own, -jnp.inf)
        p = jax.nn.softmax(jnp.concatenate([s_sel.reshape(H, QC, topk * BLK), s_own], axis=-1), axis=-1)
        p_sel = p[..., :topk * BLK].reshape(H, QC, topk, BLK).astype(v_sel.dtype)
        p_own = p[..., topk * BLK:].astype(v_own.dtype)
        o = jnp.einsum('hqtk,hqtkd->hqd', p_sel, v_sel) + jnp.einsum('hqk,hkd->hqd', p_own, v_own)
        return o.astype(qc.dtype)

    o = lax.map(chunk_fn, (q_ch, sel_ch, b_idx, c_idx))
    o = o.reshape(bsz, n_qc, H, QC, D).transpose(0, 1, 3, 2, 4).reshape(bsz, seq_p, H * D)
    return o[:, :seq]


def setup_inputs(seed: int = 0) -> dict:
    key = jax.random.key(seed)
    ks = jax.random.split(key, 20)
    f32 = jnp.float32

    def normal(k, shape, scale):
        return jax.random.normal(k, shape, f32) * scale

    def gain(k, n):
        return 1.0 + 0.02 * jax.random.normal(k, (DEPTH, n), f32)

    dt = jnp.exp(jax.random.uniform(ks[9], (DEPTH, GDN_HEADS), f32, math.log(1e-3), math.log(1e-1)))
    return {
        "x": normal(ks[0], (BATCH, SEQ, D_MODEL), 1.0),
        "ffn1_norm": gain(ks[1], D_MODEL),
        "ffn1_w_gate": normal(ks[2], (DEPTH, D_MODEL, D_FF), D_MODEL ** -0.5),
        "ffn1_w_up": normal(ks[3], (DEPTH, D_MODEL, D_FF), D_MODEL ** -0.5),
        "ffn1_w_down": normal(ks[4], (DEPTH, D_FF, D_MODEL), D_FF ** -0.5),
        "mix_norm": gain(ks[5], D_MODEL),
        "w_in": normal(ks[6], (DEPTH, D_MODEL, IN_PROJ_DIM), D_MODEL ** -0.5),
        "gdn_conv": normal(ks[7], (DEPTH, CONV_WIDTH, 3 * GDN_WIDTH), CONV_WIDTH ** -0.5),
        "gdn_a_log": jnp.log(jax.random.uniform(ks[8], (DEPTH, GDN_HEADS), f32, 1.0, 16.0)),
        "gdn_dt_bias": dt + jnp.log(-jnp.expm1(-dt)),
        "gdn_out_norm": gain(ks[10], GDN_HEAD_DIM),
        "moba_q_norm": gain(ks[11], MOBA_HEAD_DIM),
        "moba_k_norm": gain(ks[12], MOBA_HEAD_DIM),
        "w_out": normal(ks[13], (DEPTH, MIX_WIDTH, D_MODEL), MIX_WIDTH ** -0.5),
        "ffn2_norm": gain(ks[14], D_MODEL),
        "ffn2_w_gate": normal(ks[15], (DEPTH, D_MODEL, D_FF), D_MODEL ** -0.5),
        "ffn2_w_up": normal(ks[16], (DEPTH, D_MODEL, D_FF), D_MODEL ** -0.5),
        "ffn2_w_down": normal(ks[17], (DEPTH, D_FF, D_MODEL), D_FF ** -0.5),
    }


def reference(x, ffn1_norm, ffn1_w_gate, ffn1_w_up, ffn1_w_down, mix_norm, w_in, gdn_conv,
              gdn_a_log, gdn_dt_bias, gdn_out_norm, moba_q_norm, moba_k_norm, w_out,
              ffn2_norm, ffn2_w_gate, ffn2_w_up, ffn2_w_down):
    for l in range(DEPTH):
        x = x + 0.5 * swiglu_ffn(x, ffn1_norm[l], ffn1_w_gate[l], ffn1_w_up[l], ffn1_w_down[l])
        h = rms_norm(x, mix_norm[l])
        p = h @ w_in[l]
        qkv = jax.nn.silu(causal_dwconv(p[..., :OFF_GDN_QKV], gdn_conv[l]))
        g_q = qkv[..., :GDN_WIDTH]
        g_k = qkv[..., GDN_WIDTH:2 * GDN_WIDTH]
        g_v = qkv[..., 2 * GDN_WIDTH:]
        g_z = p[..., OFF_GDN_QKV:OFF_GDN_Z]
        g_a = p[..., OFF_GDN_Z:OFF_GDN_A]
        g_b = p[..., OFF_GDN_A:OFF_GDN_B]
        o_gdn = gated_deltanet(g_q, g_k, g_v, g_z, g_a, g_b, gdn_a_log[l], gdn_dt_bias[l], gdn_out_norm[l])
        o_moba = moba_attention(p[..., OFF_GDN_B:OFF_MOBA_Q], p[..., OFF_MOBA_Q:OFF_MOBA_K],
                                p[..., OFF_MOBA_K:], moba_q_norm[l], moba_k_norm[l])
        x = x + jnp.concatenate([o_gdn, o_moba], axis=-1) @ w_out[l]
        x = x + 0.5 * swiglu_ffn(x, ffn2_norm[l], ffn2_w_gate[l], ffn2_w_up[l], ffn2_w_down[l])
    return x
```

```cpp
#include <hip/hip_runtime.h>
#include <hip/hip_cooperative_groups.h>
#include <cstdio>
namespace cg = cooperative_groups;

#define LAS __attribute__((address_space(3)))
typedef unsigned short bf16_t;
typedef short bf16x8 __attribute__((ext_vector_type(8)));
typedef float f32x4 __attribute__((ext_vector_type(4)));
typedef float f32x2 __attribute__((ext_vector_type(2)));
typedef unsigned u32x4 __attribute__((ext_vector_type(4)));
typedef unsigned u32x2 __attribute__((ext_vector_type(2)));
typedef __bf16 bf16x2_t __attribute__((ext_vector_type(2)));

#ifndef PH_MASK
#define PH_MASK 0xfff
#endif
#ifndef REP
#define REP 0
#endif
#ifndef N_LAUNCH_MODE
#define N_LAUNCH_MODE 1
#endif

constexpr int T = 32768, DM = 1024, FF = 2816, SEQ = 4096;
constexpr float EPS = 1e-6f;
constexpr int LDS_BYTES = 159744;
constexpr int PA_LD = 2560;
constexpr size_t WS_X = 0;
constexpr size_t WS_R1 = WS_X + (size_t)T * 1024 * 2;
constexpr size_t WS_O = WS_R1 + (size_t)T * FF * 2;
constexpr size_t WS_WN = WS_O + (size_t)T * 1024 * 2;
constexpr size_t WS_QD = WS_WN + (size_t)2048 * 8192 * 2;
constexpr size_t WS_KD = WS_QD + (size_t)2048 * 8192 * 2;
constexpr size_t WS_US = WS_KD + (size_t)2048 * 8192 * 2;
constexpr size_t WS_AI = WS_US + (size_t)2048 * 8192 * 2;
constexpr size_t WS_WGU1 = WS_AI + (size_t)2048 * 4096 * 2;
constexpr size_t WS_WD1 = WS_WGU1 + (size_t)5632 * 1024 * 2;
constexpr size_t WS_WGU2 = WS_WD1 + (size_t)1024 * FF * 2;
constexpr size_t WS_WD2 = WS_WGU2 + (size_t)5632 * 1024 * 2;
constexpr size_t WS_WIN = WS_WD2 + (size_t)1024 * FF * 2;
constexpr size_t WS_WOUT = WS_WIN + (size_t)3584 * 1024 * 2;
constexpr size_t WS_WAB = WS_WOUT + (size_t)1024 * 1024 * 2;
constexpr size_t WS_SS1 = WS_WAB + 16 * 1024 * 2;
constexpr size_t WS_SS2 = WS_SS1 + (size_t)T * 4;
constexpr size_t WS_SS3 = WS_SS2 + (size_t)T * 4;
constexpr size_t WS_AB = WS_SS3 + (size_t)T * 4;
constexpr size_t WS_KMEAN = WS_AB + (size_t)T * 8 * 4;
constexpr size_t WS_GLAST = WS_KMEAN + (size_t)8 * 8 * 16 * 64 * 4;
constexpr size_t WS_CTR = WS_GLAST + 2048 * 4;
constexpr size_t WS_END = WS_CTR + 4096;
constexpr size_t X_VT = (size_t)T * 512 * 2;

struct Params {
    const float* in[18];
    float* out;
    unsigned char* ws;
    int ph_lo, ph_hi;
};
enum { I_X = 0, I_F1N, I_F1G, I_F1U, I_F1D, I_MIXN, I_WIN, I_CONV, I_ALOG, I_DTB, I_ONORM, I_QNORM, I_KNORM, I_WOUT, I_F2N, I_F2G, I_F2U, I_F2D };

__device__ __forceinline__ unsigned pk2(float a, float b) { f32x2 v = {a, b}; bf16x2_t r = __builtin_convertvector(v, bf16x2_t); return __builtin_bit_cast(unsigned, r); }
__device__ __forceinline__ float bf2f(bf16_t h) { return __uint_as_float((unsigned)h << 16); }
__device__ __forceinline__ float bflo(unsigned w) { return __uint_as_float(w << 16); }
__device__ __forceinline__ float bfhi(unsigned w) { return __uint_as_float(w & 0xffff0000u); }
__device__ __forceinline__ bf16_t f2bf(float a) { return (bf16_t)(pk2(a, 0.f) & 0xffffu); }
__device__ __forceinline__ float fast_sigmoid(float g) { return __builtin_amdgcn_rcpf(1.f + __builtin_amdgcn_exp2f(-1.44269504f * g)); }
__device__ __forceinline__ float silu_f(float g) { return g * fast_sigmoid(g); }
__device__ __forceinline__ bf16x8 pack8(const f32x4& a, const f32x4& b) { u32x4 p = {pk2(a[0], a[1]), pk2(a[2], a[3]), pk2(b[0], b[1]), pk2(b[2], b[3])}; return __builtin_bit_cast(bf16x8, p); }
#define MFMA16(a, b, c) __builtin_amdgcn_mfma_f32_16x16x32_bf16((a), (b), (c), 0, 0, 0)
__device__ __forceinline__ int pos32(int a) { return 8 * ((a >> 2) & 3) + 4 * (a >> 4) + (a & 3); }
__device__ __forceinline__ int act32(int p) { return 16 * ((p >> 2) & 1) + 4 * (p >> 3) + (p & 3); }

namespace pg8 {
constexpr int BM = 256, BK = 64, HALF = 128, HTB = HALF * BK * 2, STAGE_BYTES = 8 * HTB, NXCD = 8, WGM = 8;
__host__ __device__ __forceinline__ int lds_byte(int r, int c) { const int st = (r >> 4) * 2 + (c >> 5), rr = r & 15, cc = c & 31, ob = rr * 64 + cc * 2; return st * 1024 + (ob ^ (((ob >> 9) & 1) << 5)); }
__host__ __device__ __forceinline__ void stage_rc(int b, int& R, int& C) { const int st = b / 1024, sb = b % 1024, swz = sb ^ (((sb >> 9) & 1) << 5); R = (st >> 1) * 16 + swz / 64; C = (st & 1) * 32 + (swz % 64) / 2; }
__host__ __device__ __forceinline__ int perm32(int rho) { const int n = rho >> 4, i = rho & 15; return 8 * (i >> 2) + 4 * n + (i & 3); }
struct Unit { int pm, pn; };
struct Gemm { const bf16_t* A; const bf16_t* Bt; int M, N, K; };
struct StaticOrder {
    int nM, nN, nwg, G, c;
    __device__ void init(int M, int N, int G_, int c_) { nM = M / BM; nN = N / BM; nwg = nM * nN; G = G_; c = c_; }
    __device__ bool next(int i, Unit& u) const {
        const long L = (long)i * G + c; if (L >= nwg) return false;
        int wgid = (int)L; { const int q = nwg / NXCD, r = nwg % NXCD, xcd = wgid % NXCD, off = wgid / NXCD; wgid = (xcd < r ? xcd * (q + 1) : r * (q + 1) + (xcd - r) * q) + off; }
        const int nig = WGM * nN, gid = wgid / nig, fm = gid * WGM, gsz = (nM - fm) < WGM ? (nM - fm) : WGM;
        u.pm = fm + ((wgid % nig) % gsz); u.pn = (wgid % nig) / gsz; return true;
    }
};
template <class Epi>
__device__ __forceinline__ void gemm_phase(LAS unsigned char* lds, const Gemm g, const StaticOrder& S, const Epi& E) {
    const int tid = threadIdx.x, wid = __builtin_amdgcn_readfirstlane(tid >> 6), lane = tid & 63, wr = wid >> 2, wc = wid & 3, fr = lane & 15, fq = lane >> 4;
    const int K = g.K, nt = K / BK;
    unsigned voffA[2], voffB[2];
#pragma unroll
    for (int i = 0; i < 2; ++i) { int R, C; stage_rc(tid * 16 + i * 8192, R, C); const int Rb = (R & ~31) + perm32(R & 31);
        voffA[i] = (unsigned)(R * K + C) * 2u; voffB[i] = (unsigned)(Rb * K + C) * 2u; }
    const size_t kstep = (size_t)(BK * 2);
    const size_t hstep = (size_t)HALF * K * 2;
    const size_t tstep = 2 * hstep;
    const unsigned ldsw = (unsigned)wid * 1024u;
    const int aoff = lds_byte(wr * 64 + fr, fq * 8), boff = lds_byte(wc * 32 + fr, fq * 8);
#define PG8_SA(b, h) (((b) * 2 + (h)) * HTB)
#define PG8_SB(b, h) ((4 + (b) * 2 + (h)) * HTB)
#define PG8_STAGE(bufoff, gbase, voff) do { _Pragma("unroll") for (int _i = 0; _i < 2; ++_i) \
        __builtin_amdgcn_global_load_lds((const unsigned*)((const char*)(gbase) + (voff)[_i]), (LAS unsigned*)(lds + (bufoff) + ldsw + _i * 8192), 16, 0, 0); } while (0)
#define PG8_LDA(dst, b, h) do { _Pragma("unroll") for (int m = 0; m < 4; ++m) _Pragma("unroll") for (int k = 0; k < 2; ++k) dst[m][k] = *(const LAS bf16x8*)(lds + PG8_SA(b, h) + aoff + m * 2048 + k * 1024); } while (0)
#define PG8_LDB(dst, b, h) do { _Pragma("unroll") for (int n = 0; n < 2; ++n) _Pragma("unroll") for (int k = 0; k < 2; ++k) dst[n][k] = *(const LAS bf16x8*)(lds + PG8_SB(b, h) + boff + n * 2048 + k * 1024); } while (0)
#define PG8_MMA(ai, bj, At, Bt) do { __builtin_amdgcn_s_setprio(1); _Pragma("unroll") for (int m = 0; m < 4; ++m) _Pragma("unroll") for (int n = 0; n < 2; ++n) _Pragma("unroll") for (int k = 0; k < 2; ++k) \
        acc[ai][bj][m][n] = __builtin_amdgcn_mfma_f32_16x16x32_bf16(Bt[n][k], At[m][k], acc[ai][bj][m][n], 0, 0, 0); __builtin_amdgcn_s_setprio(0); } while (0)
#define PG8_WAIT_V(n) asm volatile("s_waitcnt vmcnt(" #n ")" ::: "memory")
#define PG8_WAIT_L(n) asm volatile("s_waitcnt lgkmcnt(" #n ")" ::: "memory")
#define PG8_BAR __builtin_amdgcn_s_barrier()
#define PG8_SCHED __builtin_amdgcn_sched_barrier(0)
    Unit cur, nxt; int ui = 0;
    if (!S.next(0, cur)) return;
    f32x4 acc[2][2][4][2];
#pragma unroll
    for (int a = 0; a < 2; ++a)
#pragma unroll
        for (int b = 0; b < 2; ++b)
#pragma unroll
            for (int m = 0; m < 4; ++m)
#pragma unroll
                for (int n = 0; n < 2; ++n) acc[a][b][m][n] = (f32x4){0.f, 0.f, 0.f, 0.f};
    bf16x8 At[4][2], B0[2][2], B1[2][2];
    const char* cA = (const char*)g.A + (size_t)cur.pm * tstep; const char* cB = (const char*)g.Bt + (size_t)cur.pn * tstep;
    PG8_STAGE(PG8_SB(0, 0), cB, voffB); PG8_STAGE(PG8_SA(0, 0), cA, voffA); PG8_STAGE(PG8_SB(0, 1), cB + hstep, voffB); PG8_STAGE(PG8_SA(0, 1), cA + hstep, voffA);
    if (wr == 1) PG8_BAR;
    PG8_WAIT_V(4); PG8_BAR;
    PG8_STAGE(PG8_SB(1, 0), cB + kstep, voffB); PG8_STAGE(PG8_SA(1, 0), cA + kstep, voffA); PG8_STAGE(PG8_SB(1, 1), cB + hstep + kstep, voffB);
    PG8_WAIT_V(6); PG8_BAR;
    for (;;) {
        const bool has_next = S.next(ui + 1, nxt);
        const char* nA = has_next ? (const char*)g.A + (size_t)nxt.pm * tstep : cA; const char* nB = has_next ? (const char*)g.Bt + (size_t)nxt.pn * tstep : cB;
        for (int t = 0; t < nt; t += 2) {
            const bool last = (t == nt - 2);
            const char* a1 = cA + (size_t)(t + 1) * kstep;
            const char* a2 = last ? nA : cA + (size_t)(t + 2) * kstep; const char* b2 = last ? nB : cB + (size_t)(t + 2) * kstep;
            const char* a3 = a2 + kstep; const char* b3 = b2 + kstep;
            PG8_LDB(B0, 0, 0); PG8_SCHED; PG8_LDA(At, 0, 0); PG8_STAGE(PG8_SA(1, 1), a1 + hstep, voffA);
            PG8_WAIT_L(8); PG8_BAR; PG8_WAIT_L(0); PG8_MMA(0, 0, At, B0); PG8_BAR; PG8_SCHED;
            PG8_LDB(B1, 0, 1); PG8_STAGE(PG8_SB(0, 0), b2, voffB);
            PG8_BAR; PG8_WAIT_L(0); PG8_MMA(0, 1, At, B1); PG8_BAR;
            PG8_LDA(At, 0, 1); PG8_STAGE(PG8_SA(0, 0), a2, voffA);
            PG8_BAR; PG8_WAIT_L(0); PG8_MMA(1, 0, At, B0); PG8_BAR; PG8_SCHED;
            PG8_STAGE(PG8_SB(0, 1), b2 + hstep, voffB);
            PG8_WAIT_V(6); PG8_BAR; PG8_MMA(1, 1, At, B1); PG8_BAR;
            PG8_LDB(B0, 1, 0); PG8_SCHED; PG8_LDA(At, 1, 0); PG8_STAGE(PG8_SA(0, 1), a2 + hstep, voffA);
            PG8_WAIT_L(8); PG8_BAR; PG8_WAIT_L(0); PG8_MMA(0, 0, At, B0); PG8_BAR; PG8_SCHED;
            PG8_LDB(B1, 1, 1); PG8_STAGE(PG8_SB(1, 0), b3, voffB);
            PG8_BAR; PG8_WAIT_L(0); PG8_MMA(0, 1, At, B1); PG8_BAR;
            PG8_LDA(At, 1, 1); PG8_STAGE(PG8_SA(1, 0), a3, voffA);
            PG8_BAR; PG8_WAIT_L(0); PG8_MMA(1, 0, At, B0); PG8_BAR; PG8_SCHED;
            PG8_STAGE(PG8_SB(1, 1), b3 + hstep, voffB);
            PG8_WAIT_V(6); PG8_BAR; PG8_MMA(1, 1, At, B1); PG8_BAR;
        }
        E(acc, cur, ui, wr, wc, fr, fq);
        if (!has_next) break;
#pragma unroll
        for (int a = 0; a < 2; ++a)
#pragma unroll
            for (int b = 0; b < 2; ++b)
#pragma unroll
                for (int m = 0; m < 4; ++m)
#pragma unroll
                    for (int n = 0; n < 2; ++n) acc[a][b][m][n] = (f32x4){0.f, 0.f, 0.f, 0.f};
        cur = nxt; cA = nA; cB = nB; ++ui;
    }
    PG8_WAIT_V(0);
    if (wr == 0) PG8_BAR;
    PG8_BAR;
#undef PG8_SA
#undef PG8_SB
#undef PG8_STAGE
#undef PG8_LDA
#undef PG8_LDB
#undef PG8_MMA
#undef PG8_WAIT_V
#undef PG8_WAIT_L
#undef PG8_BAR
#undef PG8_SCHED
}
}
using pg8::Unit;

constexpr int RT_OFF = 131072;
template <bool SCALE> struct EpiSwiGLU {
    bf16_t* act; const LAS float* rt;
    __device__ __forceinline__ void operator()(const f32x4 (&acc)[2][2][4][2], const Unit& u, int ui, int wr, int wc, int fr, int fq) const {
        const int row0 = u.pm * 256 + wr * 64 + fr, col0 = u.pn * 128 + wc * 32 + 8 * fq; const LAS float* rtu = rt + ui * 256 + wr * 64 + fr;
        float rs[2][4];
#pragma unroll
        for (int ai = 0; ai < 2; ++ai)
#pragma unroll
            for (int m = 0; m < 4; ++m) rs[ai][m] = SCALE ? rtu[ai * 128 + m * 16] : 1.f;
#pragma unroll
        for (int ai = 0; ai < 2; ++ai)
#pragma unroll
            for (int m = 0; m < 4; ++m) {
                const int row = row0 + ai * 128 + m * 16;
                const float r = rs[ai][m];
                float hv[8];
#pragma unroll
                for (int n = 0; n < 2; ++n)
#pragma unroll
                    for (int j = 0; j < 4; ++j) { const float g = acc[ai][0][m][n][j] * r, up = acc[ai][1][m][n][j] * r; hv[4 * n + j] = silu_f(g) * up; }
                u32x4 w = {pk2(hv[0], hv[1]), pk2(hv[2], hv[3]), pk2(hv[4], hv[5]), pk2(hv[6], hv[7])};
                *(u32x4*)(act + (size_t)row * FF + col0) = w;
            }
    }
};
template <int MODE> struct EpiResid {
    const float* residf; const bf16_t* residb; float* outf; bf16_t* outb; float* ss; float scale;
    __device__ __forceinline__ void operator()(const f32x4 (&acc)[2][2][4][2], const Unit& u, int ui, int wr, int wc, int fr, int fq) const {
        const int row0 = u.pm * 256 + wr * 64 + fr, col0 = u.pn * 256 + wc * 32 + 8 * fq;
        u32x4 rball[MODE == 0 ? 1 : 2][MODE == 0 ? 1 : 4][2];
        if constexpr (MODE != 0) {
#pragma unroll
            for (int ai = 0; ai < 2; ++ai)
#pragma unroll
                for (int m = 0; m < 4; ++m)
#pragma unroll
                    for (int bj = 0; bj < 2; ++bj) rball[ai][m][bj] = *(const u32x4*)(residb + (size_t)(row0 + ai * 128 + m * 16) * 1024 + col0 + bj * 128);
        }
#pragma unroll
        for (int ai = 0; ai < 2; ++ai) {
            f32x4 rf[MODE == 0 ? 4 : 1][2][2];
            if constexpr (MODE == 0) {
#pragma unroll
                for (int m = 0; m < 4; ++m)
#pragma unroll
                    for (int bj = 0; bj < 2; ++bj) { const size_t off = (size_t)(row0 + ai * 128 + m * 16) * 1024 + col0 + bj * 128;
                        rf[m][bj][0] = *(const f32x4*)(residf + off); rf[m][bj][1] = *(const f32x4*)(residf + off + 4); }
            }
#pragma unroll
            for (int m = 0; m < 4; ++m) {
                const int row = row0 + ai * 128 + m * 16; float sq = 0.f;
#pragma unroll
                for (int bj = 0; bj < 2; ++bj) {
                    const size_t off = (size_t)row * 1024 + col0 + bj * 128;
                    f32x4 r0, r1;
                    if constexpr (MODE == 0) { r0 = rf[m][bj][0]; r1 = rf[m][bj][1]; }
                    else { const u32x4 q = rball[MODE == 0 ? 0 : ai][MODE == 0 ? 0 : m][bj]; r0 = (f32x4){bflo(q[0]), bfhi(q[0]), bflo(q[1]), bfhi(q[1])}; r1 = (f32x4){bflo(q[2]), bfhi(q[2]), bflo(q[3]), bfhi(q[3])}; }
                    const f32x4 v0 = r0 + scale * acc[ai][bj][m][0], v1 = r1 + scale * acc[ai][bj][m][1];
                    if constexpr (MODE == 2) { *(f32x4*)(outf + off) = v0; *(f32x4*)(outf + off + 4) = v1; }
                    else { u32x4 w = {pk2(v0[0], v0[1]), pk2(v0[2], v0[3]), pk2(v1[0], v1[1]), pk2(v1[2], v1[3])}; *(u32x4*)(outb + off) = w;
                        sq += v0[0] * v0[0] + v0[1] * v0[1] + v0[2] * v0[2] + v0[3] * v0[3] + v1[0] * v1[0] + v1[1] * v1[1] + v1[2] * v1[2] + v1[3] * v1[3]; }
                }
                if constexpr (MODE != 2) { if (ss) { sq += __shfl_xor(sq, 16); sq += __shfl_xor(sq, 32); if (fq == 0) unsafeAtomicAdd(ss + row, sq); } }
            }
        }
    }
};
struct EpiInProj {
    bf16_t* Pa; bf16_t* Pb; const LAS float* rt;
    __device__ __forceinline__ void operator()(const f32x4 (&acc)[2][2][4][2], const Unit& u, int ui, int wr, int wc, int fr, int fq) const {
        const int row0 = u.pm * 256 + wr * 64 + fr, col0 = u.pn * 256 + wc * 32 + 8 * fq;
        const bool toA = u.pn < 10; const LAS float* rtu = rt + ui * 256 + wr * 64 + fr;
#pragma unroll
        for (int ai = 0; ai < 2; ++ai)
#pragma unroll
            for (int m = 0; m < 4; ++m) {
                const int row = row0 + ai * 128 + m * 16;
                const float r = rtu[ai * 128 + m * 16];
#pragma unroll
                for (int bj = 0; bj < 2; ++bj) {
                    const f32x4 v0 = acc[ai][bj][m][0] * r, v1 = acc[ai][bj][m][1] * r;
                    u32x4 w = {pk2(v0[0], v0[1]), pk2(v0[2], v0[3]), pk2(v1[0], v1[1]), pk2(v1[2], v1[3])};
                    const int col = col0 + bj * 128;
                    bf16_t* dst = toA ? Pa + (size_t)row * PA_LD + col : Pb + (size_t)row * 1024 + (col - 2560);
                    *(u32x4*)dst = w;
                }
            }
    }
};

__device__ __forceinline__ float wave_sum(float v) {
#pragma unroll
    for (int o = 1; o < 64; o <<= 1) v += __shfl_xor(v, o);
    return v;
}
__device__ __forceinline__ void transpose_item(const float* src, int ldsrc, int K, int k0, int c0, bf16_t* dst, int r0, const float* gain, LAS float* scr, int lane) {
    float v[32];
    const float* sp = src + (size_t)(k0 + (lane >> 5)) * ldsrc + c0 + (lane & 31);
#pragma unroll
    for (int i = 0; i < 32; ++i) v[i] = sp[(size_t)(2 * i) * ldsrc];
    if (gain) {
#pragma unroll
        for (int i = 0; i < 32; ++i) v[i] *= gain[k0 + 2 * i + (lane >> 5)];
    }
#pragma unroll
    for (int i = 0; i < 32; ++i) scr[(2 * i + (lane >> 5)) * 33 + (lane & 31)] = v[i];
    __builtin_amdgcn_wave_barrier();
    const int c = lane & 7;
#pragma unroll
    for (int j = 0; j < 4; ++j) { const int n = (lane >> 3) + 8 * j; const LAS float* sq = scr + (8 * c) * 33 + n;
        u32x4 o = {pk2(sq[0], sq[33]), pk2(sq[66], sq[99]), pk2(sq[132], sq[165]), pk2(sq[198], sq[231])};
        *(u32x4*)(dst + (size_t)(r0 + n) * K + k0 + 8 * c) = o; }
    __builtin_amdgcn_wave_barrier();
}
__device__ __forceinline__ void phase_prep(const Params& p, LAS unsigned char* lds) {
    const int tid = threadIdx.x, nb = gridDim.x, bid = blockIdx.x, wave = tid >> 6, lane = tid & 63;
    unsigned char* ws = p.ws;
    float* ss1 = (float*)(ws + WS_SS1); float* ss2 = (float*)(ws + WS_SS2); float* ss3 = (float*)(ws + WS_SS3);
    for (int i = bid * 512 + tid; i < T; i += nb * 512) { ss2[i] = 0.f; ss3[i] = 0.f; }
    if (bid == 0 && wave == 1) {
        float gq = fabsf(p.in[I_QNORM][lane]), gk = fabsf(p.in[I_KNORM][lane]);
#pragma unroll
        for (int o = 1; o < 64; o <<= 1) { gq = fmaxf(gq, __shfl_xor(gq, o)); gk = fmaxf(gk, __shfl_xor(gk, o)); }
        if (lane == 0) ((float*)(ws + WS_CTR))[32] = fminf(0.18033688f * 64.f * 1.02f * gq * gk, 60.f);
    }
    { bf16_t* wab = (bf16_t*)(ws + WS_WAB); const float* win = p.in[I_WIN]; const float* gn = p.in[I_MIXN];
      for (int idx = bid * 512 + tid; idx < 16 * 1024; idx += nb * 512) { const int n = idx >> 10, k = idx & 1023;
          wab[idx] = n < 8 ? f2bf(win[(size_t)k * 3592 + 2048 + n] * gn[k]) : (bf16_t)0; } }
    { const float* x = p.in[I_X]; bf16_t* xb = (bf16_t*)(ws + WS_X);
      for (int row = bid * 8 + wave; row < T; row += nb * 8) {
          const f32x4* xr = (const f32x4*)(x + (size_t)row * 1024); f32x4 v[4]; float s = 0.f;
#pragma unroll
          for (int j = 0; j < 4; ++j) { v[j] = xr[lane + 64 * j]; s += v[j][0] * v[j][0] + v[j][1] * v[j][1] + v[j][2] * v[j][2] + v[j][3] * v[j][3]; }
          s = wave_sum(s); if (lane == 0) ss1[row] = s;
          const float rn = rsqrtf(s * (1.f / 1024.f) + EPS);
          u32x2* o = (u32x2*)(xb + (size_t)row * 1024);
#pragma unroll
          for (int j = 0; j < 4; ++j) { u32x2 w = {pk2(v[j][0] * rn, v[j][1] * rn), pk2(v[j][2] * rn, v[j][3] * rn)}; o[lane + 64 * j] = w; }
      } }
    LAS float* scr = (LAS float*)(lds + wave * 8448);
    constexpr int N_GU = 88 * 16, N_D = 16 * 44, N_IN = 56 * 16, N_OUT = 16 * 16, N_ALL = 2 * (N_GU + N_D) + N_IN + N_OUT;
    for (int wi = bid * 8 + wave; wi < 2 * N_ALL; wi += nb * 8) {
        int r = wi >> 1; const int hf = (wi & 1) * 32;
        if (r < 2 * N_GU) { const int f = r / N_GU; r -= f * N_GU; const int rt = r >> 4, kt = r & 15, r0 = rt * 64;
            const int pn = r0 >> 8, bj = (r0 >> 7) & 1, rr = r0 & 127;
            const float* src = bj ? p.in[f ? I_F2U : I_F1U] : p.in[f ? I_F2G : I_F1G];
            transpose_item(src, FF, 1024, kt * 64, pn * 128 + rr + hf, (bf16_t*)(ws + (f ? WS_WGU2 : WS_WGU1)), r0 + hf, p.in[f ? I_F2N : I_F1N], scr, lane); continue; }
        r -= 2 * N_GU;
        if (r < 2 * N_D) { const int f = r / N_D; r -= f * N_D; const int rt = r / 44, kt = r % 44;
            transpose_item(p.in[f ? I_F2D : I_F1D], 1024, FF, kt * 64, rt * 64 + hf, (bf16_t*)(ws + (f ? WS_WD2 : WS_WD1)), rt * 64 + hf, nullptr, scr, lane); continue; }
        r -= 2 * N_D;
        if (r < N_IN) { const int rt = r >> 4, kt = r & 15, r0 = rt * 64;
            transpose_item(p.in[I_WIN], 3592, 1024, kt * 64, (r0 < 2048 ? r0 : r0 + 8) + hf, (bf16_t*)(ws + WS_WIN), r0 + hf, p.in[I_MIXN], scr, lane); continue; }
        r -= N_IN;
        { const int rt = r >> 4, kt = r & 15; transpose_item(p.in[I_WOUT], 1024, 1024, kt * 64, rt * 64 + hf, (bf16_t*)(ws + WS_WOUT), rt * 64 + hf, nullptr, scr, lane); }
    }
}

__device__ __forceinline__ void ab_rows(const Params& p) {
    const int tid = threadIdx.x, wave = tid >> 6, lane = tid & 63, fr = lane & 15, fq = lane >> 4;
    const bf16_t* x1b = (const bf16_t*)(p.ws + WS_X); const bf16_t* wab = (const bf16_t*)(p.ws + WS_WAB);
    const float* ss2 = (const float*)(p.ws + WS_SS2); float* ab = (float*)(p.ws + WS_AB);
    for (int wt = blockIdx.x * 8 + wave; wt < T / 16; wt += gridDim.x * 8) {
        const int row0 = wt * 16;
        const bf16_t* arow = x1b + (size_t)(row0 + fr) * 1024 + fq * 8; const bf16_t* brow = wab + (size_t)fr * 1024 + fq * 8;
        f32x4 acc = {0.f, 0.f, 0.f, 0.f};
#pragma unroll 8
        for (int ks = 0; ks < 32; ++ks) { const bf16x8 a = *(const bf16x8*)(arow + ks * 32), b = *(const bf16x8*)(brow + ks * 32); acc = MFMA16(a, b, acc); }
        if (fr < 8) {
#pragma unroll
            for (int j = 0; j < 4; ++j) { const int row = row0 + 4 * fq + j; ab[(size_t)row * 8 + fr] = acc[j] * rsqrtf(ss2[row] * (1.f / 1024.f) + EPS); }
        }
    }
}

constexpr int G1_HALF = 78080;
__device__ __forceinline__ void g1_item(const Params& p, LAS unsigned char* lds, int item) {
    int tid = threadIdx.x; asm volatile("" : "+v"(tid));
    const int hh = tid >> 8, tl = tid & 255, lane = tid & 63, wv4 = tl >> 6, fr = lane & 15, fq = lane >> 4;
    const int hp = item & 1, n = (item >> 1) & 63, b = item >> 7, h = 2 * hp + hh;
    const int chh = (b * 4 + h) * 64 + n, t0 = b * SEQ + n * 64;
    LAS unsigned char* base = lds + hh * G1_HALF;
    LAS bf16_t* Kb = (LAS bf16_t*)base; LAS bf16_t* Qb = (LAS bf16_t*)(base + 17408); LAS bf16_t* Vb = (LAS bf16_t*)(base + 34816);
    LAS float* Lm = (LAS float*)(base + 52224); LAS bf16_t* Ais = (LAS bf16_t*)(base + 68608);
    LAS float* gc = (LAS float*)(base + 76800); LAS float* beta = gc + 64; LAS float* eg = gc + 128;
    const bf16_t* Pa = (const bf16_t*)(p.ws + WS_R1);
    {
        const int dg = tl & 15, tg = tl >> 4, d0 = 8 * dg;
#pragma unroll
        for (int sec = 0; sec < 3; ++sec) {
            const int col = sec * 512 + h * 128 + d0;
            float w[4][8];
#pragma unroll
            for (int kk = 0; kk < 4; ++kk) { const f32x4 wa = *(const f32x4*)(p.in[I_CONV] + kk * 1536 + col), wb = *(const f32x4*)(p.in[I_CONV] + kk * 1536 + col + 4);
#pragma unroll
                for (int e = 0; e < 4; ++e) { w[kk][e] = wa[e]; w[kk][4 + e] = wb[e]; } }
            u32x4 xr[7];
#pragma unroll
            for (int rr = 0; rr < 7; ++rr) { const int tok = n * 64 + 4 * tg - 3 + rr;
                if (tok >= 0) xr[rr] = *(const u32x4*)(Pa + (size_t)(b * SEQ + tok) * PA_LD + col); else xr[rr] = (u32x4){0u, 0u, 0u, 0u}; }
            LAS bf16_t* dstb = sec == 0 ? Qb : (sec == 1 ? Kb : Vb);
#pragma unroll
            for (int ti = 0; ti < 4; ++ti) {
                float y[8]; float ssq = 0.f;
#pragma unroll
                for (int e = 0; e < 8; ++e) { float a = 0.f;
#pragma unroll
                    for (int kk = 0; kk < 4; ++kk) { const unsigned wd = xr[ti + kk][e >> 1]; a += w[kk][e] * ((e & 1) ? bfhi(wd) : bflo(wd)); }
                    y[e] = silu_f(a); ssq += y[e] * y[e]; }
                if (sec < 2) {
                    ssq += __shfl_xor(ssq, 1); ssq += __shfl_xor(ssq, 2); ssq += __shfl_xor(ssq, 4); ssq += __shfl_xor(ssq, 8);
                    const float rn = rsqrtf(ssq + EPS) * (sec == 0 ? 0.08838834764831845f : 1.f);
#pragma unroll
                    for (int e = 0; e < 8; ++e) y[e] *= rn;
                }
                u32x4 o = {pk2(y[0], y[1]), pk2(y[2], y[3]), pk2(y[4], y[5]), pk2(y[6], y[7])};
                *(LAS u32x4*)(dstb + (4 * tg + ti) * 136 + d0) = o;
            }
        }
    }
    if (tl < 64) {
        const int i = tl; const float* ab = (const float*)(p.ws + WS_AB);
        const float a = ab[(size_t)(t0 + i) * 8 + h], bb = ab[(size_t)(t0 + i) * 8 + 4 + h];
        const float A = expf(p.in[I_ALOG][h]); const float xx = a + p.in[I_DTB][h];
        const float sp = xx > 20.f ? xx : log1pf(expf(xx));
        float g = -A * sp;
#pragma unroll
        for (int off = 1; off < 64; off <<= 1) { const float t = __shfl_up(g, off); if (lane >= off) g += t; }
        const float bt = 1.f / (1.f + expf(-bb)), egi = expf(g);
        gc[i] = g; beta[i] = bt; eg[i] = egi; eg[64 + i] = bt * egi; eg[128 + i] = expf(__shfl(g, 63) - g);
        if (i == 63) ((float*)(p.ws + WS_GLAST))[chh] = expf(g);
    }
    __syncthreads();
    {
        const int mt = wv4;
#pragma unroll
        for (int nt = 0; nt < 4; ++nt) {
            f32x4 aK = {0.f, 0.f, 0.f, 0.f}, aQ = {0.f, 0.f, 0.f, 0.f};
#pragma unroll
            for (int ks = 0; ks < 4; ++ks) {
                const bf16x8 bk = *(const LAS bf16x8*)(Kb + (16 * nt + fr) * 136 + 32 * ks + 8 * fq);
                const bf16x8 ak = *(const LAS bf16x8*)(Kb + (16 * mt + fr) * 136 + 32 * ks + 8 * fq);
                const bf16x8 aq = *(const LAS bf16x8*)(Qb + (16 * mt + fr) * 136 + 32 * ks + 8 * fq);
                aK = MFMA16(ak, bk, aK); aQ = MFMA16(aq, bk, aQ);
            }
            const int j = 16 * nt + fr; const float gj = gc[j];
#pragma unroll
            for (int jj = 0; jj < 4; ++jj) { const int i = 16 * mt + 4 * fq + jj;
                const float dec = (i >= j) ? expf(gc[i] - gj) : 0.f;
                Lm[i * 64 + j] = (i > j) ? beta[i] * aK[jj] * dec : 0.f;
                Ais[i * 64 + 32 * (j >> 5) + pos32(j & 31)] = f2bf(aQ[jj] * dec); }
        }
    }
    {
        const int i = tl >> 2, g32 = tl & 3; const float sc = eg[i];
        float a[32];
#pragma unroll
        for (int c4 = 0; c4 < 4; ++c4) { const u32x4 v = *(const LAS u32x4*)(Qb + i * 136 + 32 * g32 + 8 * c4);
#pragma unroll
            for (int e = 0; e < 4; ++e) { a[8 * c4 + 2 * e] = bflo(v[e]) * sc; a[8 * c4 + 2 * e + 1] = bfhi(v[e]) * sc; } }
        bf16_t* dq = (bf16_t*)(p.ws + WS_QD) + (size_t)chh * 8192 + i * 128 + 32 * g32;
#pragma unroll
        for (int c4 = 0; c4 < 4; ++c4) { u32x4 o;
#pragma unroll
            for (int e = 0; e < 4; ++e) o[e] = pk2(a[act32(8 * c4 + 2 * e)], a[act32(8 * c4 + 2 * e + 1)]);
            *(u32x4*)(dq + 8 * c4) = o; }
    }
    {
        const int d = tl >> 1, tgp = tl & 1; const float gl = gc[63];
        bf16_t* dk = (bf16_t*)(p.ws + WS_KD) + (size_t)chh * 8192 + d * 64 + 32 * tgp;
#pragma unroll
        for (int c4 = 0; c4 < 4; ++c4) { u32x4 o;
#pragma unroll
            for (int e = 0; e < 4; ++e) { const int i0 = 32 * tgp + act32(8 * c4 + 2 * e), i1 = 32 * tgp + act32(8 * c4 + 2 * e + 1);
                o[e] = pk2(bf2f(Kb[i0 * 136 + d]) * expf(gl - gc[i0]), bf2f(Kb[i1 * 136 + d]) * expf(gl - gc[i1])); }
            *(u32x4*)(dk + 8 * c4) = o; }
    }
    __syncthreads();
#pragma unroll
    for (int ii = 0; ii < 2; ++ii) { const int id = tl + 256 * ii; *(u32x4*)((bf16_t*)(p.ws + WS_AI) + (size_t)chh * 4096 + id * 8) = *(const LAS u32x4*)(Ais + id * 8); }
    {
        const int c = tl; f32x2 xp[32];
        const LAS bf16_t* rsrc = c < 128 ? Vb + c : Kb + (c - 128);
        const LAS float* rsc = c < 128 ? beta : eg + 64;
#pragma unroll
        for (int q = 0; q < 32; ++q) xp[q] = (f32x2){0.f, 0.f};
#pragma unroll
        for (int i = 0; i < 64; ++i) {
            f32x2 acc = {rsc[i] * bf2f(rsrc[i * 136]), 0.f};
#pragma unroll
            for (int j4 = 0; j4 < (i + 3) / 4; ++j4) { const f32x4 l = *(const LAS f32x4*)(Lm + i * 64 + 4 * j4);
                acc -= (f32x2){l[0], l[1]} * xp[2 * j4]; if (4 * j4 + 2 < i) acc -= (f32x2){l[2], l[3]} * xp[2 * j4 + 1]; }
            const float xi = acc[0] + acc[1];
            if (i & 1) xp[i >> 1][1] = xi; else xp[i >> 1][0] = xi;
            if ((i & 3) == 3) __builtin_amdgcn_sched_barrier(0);
        }
#define x(i_) xp[(i_) >> 1][(i_) & 1]
        __syncthreads();
        LAS bf16_t* stg = (LAS bf16_t*)base;
        if (c < 128) {
            LAS bf16_t* us = stg + 8192 + (c >> 4) * 1024 + (c & 15) * 4;
#pragma unroll
            for (int mt = 0; mt < 4; ++mt)
#pragma unroll
                for (int q = 0; q < 4; ++q) { const int i = 16 * mt + 4 * q; u32x2 o = {pk2(x(i), x(i + 1)), pk2(x(i + 2), x(i + 3))}; *(LAS u32x2*)(us + mt * 256 + q * 64) = o; }
        } else {
            const int kd = c - 128; LAS bf16_t* wn = stg + 32 * (kd >> 5) + pos32(kd & 31);
#pragma unroll
            for (int i = 0; i < 64; ++i) wn[i * 128] = f2bf(-x(i));
        }
    }
#undef x
    __syncthreads();
    {
        LAS bf16_t* stg = (LAS bf16_t*)base;
        bf16_t* gw = (bf16_t*)(p.ws + WS_WN) + (size_t)chh * 8192; bf16_t* gu = (bf16_t*)(p.ws + WS_US) + (size_t)chh * 8192;
#pragma unroll
        for (int ii = 0; ii < 4; ++ii) { const int id = tl + 256 * ii;
            *(u32x4*)(gw + id * 8) = *(const LAS u32x4*)(stg + id * 8);
            *(u32x4*)(gu + id * 8) = *(const LAS u32x4*)(stg + 8192 + id * 8); }
    }
    __syncthreads();
}

__device__ __forceinline__ void moba_prep_item(const Params& p, LAS unsigned char* lds, int item, bool dry = false) {
    const int tid = threadIdx.x;
    const int h = item & 7, blk = (item >> 3) & 15, b = item >> 7, t0 = b * SEQ + blk * 256;
    LAS float* scr = (LAS float*)lds; LAS bf16_t* vt = (LAS bf16_t*)(lds + 66560); LAS float* part = (LAS float*)(lds + 100352);
    const bf16_t* Pa = (const bf16_t*)(p.ws + WS_R1); bf16_t* O = (bf16_t*)(p.ws + WS_O);
    bf16_t* kn = (bf16_t*)p.out; bf16_t* Vt = (bf16_t*)p.out + (size_t)T * 512;
    {
        const int key = tid >> 1, half = tid & 1;
        const bf16_t* src = O + (size_t)(t0 + key) * 1024 + 512 + h * 64 + half * 32;
        const int kp = 32 * (key >> 5) + pos32(key & 31);
#pragma unroll
        for (int c4 = 0; c4 < 4; ++c4) { const u32x4 v = *(const u32x4*)(src + 8 * c4);
#pragma unroll
            for (int e = 0; e < 4; ++e) { vt[(half * 32 + 8 * c4 + 2 * e) * 264 + kp] = (bf16_t)(v[e] & 0xffffu); vt[(half * 32 + 8 * c4 + 2 * e + 1) * 264 + kp] = (bf16_t)(v[e] >> 16); } }
    }
    __syncthreads();
    {
        const int role = tid >> 8, tok = tid & 255;
        const bf16_t* src = role == 0 ? Pa + (size_t)(t0 + tok) * PA_LD + 2048 + h * 64 : O + (size_t)(t0 + tok) * 1024 + h * 64;
        const float* gain = p.in[role == 0 ? I_QNORM : I_KNORM];
        float v[64]; float ssq = 0.f;
#pragma unroll
        for (int c8 = 0; c8 < 8; ++c8) { const u32x4 w = *(const u32x4*)(src + 8 * c8);
#pragma unroll
            for (int e = 0; e < 4; ++e) { v[8 * c8 + 2 * e] = bflo(w[e]); v[8 * c8 + 2 * e + 1] = bfhi(w[e]); } }
#pragma unroll
        for (int i = 0; i < 64; ++i) ssq += v[i] * v[i];
        const float rn = rsqrtf(ssq * (1.f / 64.f) + EPS);
#pragma unroll
        for (int i = 0; i < 64; ++i) v[i] = v[i] * rn * gain[i];
        const float posf = (float)(blk * 256 + tok);
        const float invf[8] = {1.0f, 0.1939227432012558f, 0.03760603070259094f, 0.007292664609849453f, 0.0014142135623842478f, 0.00027424818836152554f, 5.318296098266728e-05f, 1.0313386155758053e-05f};
#pragma unroll
        for (int i = 0; i < 8; ++i) {
            const float ang = posf * invf[i];
            double rev = (double)ang * 0.15915494309189535; rev -= rint(rev);
            const float sn = __builtin_amdgcn_sinf((float)rev), cs = __builtin_amdgcn_cosf((float)rev);
            const float x1 = v[i], x2 = v[i + 8];
            v[i] = x1 * cs - x2 * sn; v[i + 8] = x2 * cs + x1 * sn;
        }
        bf16_t* dst = role == 0 ? (dry ? (bf16_t*)(p.ws + WS_END) + (size_t)tok * 1024 : O + (size_t)(t0 + tok) * 1024) + 512 + h * 64 : kn + (size_t)(t0 + tok) * 512 + h * 64;
#pragma unroll
        for (int c8 = 0; c8 < 8; ++c8) { u32x4 w = {pk2(v[8 * c8], v[8 * c8 + 1]), pk2(v[8 * c8 + 2], v[8 * c8 + 3]), pk2(v[8 * c8 + 4], v[8 * c8 + 5]), pk2(v[8 * c8 + 6], v[8 * c8 + 7])};
            *(u32x4*)(dst + 8 * c8) = w; }
        if (role == 1) {
#pragma unroll
            for (int i = 0; i < 64; ++i) scr[tok * 65 + i] = v[i];
        }
    }
    __syncthreads();
    if (tid < 256) { const int d = tid & 63, pt = tid >> 6; float s = 0.f;
        for (int r = 0; r < 64; ++r) s += scr[(64 * pt + r) * 65 + d];
        part[pt * 64 + d] = s; }
#pragma unroll
    for (int ii = 0; ii < 4; ++ii) { const int id = tid + 512 * ii, d = id >> 5, cc = id & 31;
        *(u32x4*)(Vt + ((size_t)((b * 8 + h) * 16 + blk) * 64 + d) * 256 + cc * 8) = *(const LAS u32x4*)(vt + d * 264 + cc * 8); }
    __syncthreads();
    if (tid < 64) ((float*)(p.ws + WS_KMEAN))[((size_t)((b * 8 + h) * 16) + blk) * 64 + tid] = (part[tid] + part[64 + tid] + part[128 + tid] + part[192 + tid]) * (1.f / 256.f);
    __syncthreads();
}

__device__ __forceinline__ float row16_sum(float v) {
    v += __builtin_bit_cast(float, __builtin_amdgcn_update_dpp(0, __builtin_bit_cast(int, v), 0xB1, 0xF, 0xF, true));
    v += __builtin_bit_cast(float, __builtin_amdgcn_update_dpp(0, __builtin_bit_cast(int, v), 0x4E, 0xF, 0xF, true));
    v += __builtin_bit_cast(float, __builtin_amdgcn_update_dpp(0, __builtin_bit_cast(int, v), 0x141, 0xF, 0xF, true));
    v += __builtin_bit_cast(float, __builtin_amdgcn_update_dpp(0, __builtin_bit_cast(int, v), 0x140, 0xF, 0xF, true));
    return v;
}
template <int DRY>
__device__ __forceinline__ void gdn_scan(const Params& p, LAS unsigned char* lds, int bh) {
    const int tid = threadIdx.x, wv = __builtin_amdgcn_readfirstlane(tid >> 6), lane = tid & 63, fr = lane & 15, fq = lane >> 4;
    const int b = bh >> 2, h = bh & 3;
    const bool cw = wv < 4; const int w4 = wv & 3, tid2 = tid & 255;
    constexpr int W_OFF = 0, Q_OFF = 16384, K_OFF = 32768, A_OFF = 49152, BUF = 57344, OT_OFF = 2 * BUF, RED_OFF = OT_OFF + 2 * 16384;
    LAS float* red = (LAS float*)(lds + RED_OFF);
    const bf16_t* Wn = (const bf16_t*)(p.ws + WS_WN); const bf16_t* Qd = (const bf16_t*)(p.ws + WS_QD); const bf16_t* Kd = (const bf16_t*)(p.ws + WS_KD);
    const bf16_t* Ai = (const bf16_t*)(p.ws + WS_AI); const bf16_t* Us = (const bf16_t*)(p.ws + WS_US); const float* glast = (const float*)(p.ws + WS_GLAST);
    const bf16_t* Pa = (const bf16_t*)(p.ws + WS_R1); bf16_t* O = (bf16_t*)(p.ws + WS_O);
    f32x4 S[8][2];
#pragma unroll
    for (int i = 0; i < 8; ++i) { S[i][0] = (f32x4){0.f, 0.f, 0.f, 0.f}; S[i][1] = (f32x4){0.f, 0.f, 0.f, 0.f}; }
    const int fcc = tid2 & 15;
    LAS float* gainl = (LAS float*)(lds + RED_OFF + 2048);
    if (tid < 128) gainl[tid] = p.in[I_ONORM][tid];
    u32x2 ru[8]; float gl_next = 0.f;
#pragma unroll
    for (int k = 0; k < 8; ++k) ru[k] = (u32x2){0u, 0u};
    const bf16_t* rub = cw ? Us + ((size_t)bh * 64 * 8 + 2 * w4) * 1024 + lane * 4 : Pa + ((size_t)b * SEQ + (tid2 >> 4)) * PA_LD + 1536 + h * 128 + 8 * fcc;
    const size_t ru_step = cw ? (size_t)8192 : (size_t)64 * PA_LD;
    const int ru_a = cw ? 256 : 16 * PA_LD, ru_b = cw ? 1024 : 4;
#define SCAN_GLOAD(nn, zn, par) do { const size_t chh = (size_t)bh * 64 + ((DRY & 4) ? 0 : (nn)); LAS unsigned char* db = lds + ((par) & 1) * BUF + wv * 1024; \
        int lq = lane; asm volatile("" : "+v"(lq));            \
        _Pragma("unroll") for (int i = 0; i < 2; ++i) { \
            const int r16 = 4 * (wv + 8 * i) + (lq >> 4), c16 = (lq & 15) ^ (r16 & 15); const unsigned gw = (unsigned)(r16 * 128 + c16 * 8); \
            const int r8 = 8 * (wv + 8 * i) + (lq >> 3), c8 = (lq & 7) ^ ((r8 >> 1) & 7); const unsigned gk = (unsigned)(r8 * 64 + c8 * 8); \
            __builtin_amdgcn_global_load_lds((const unsigned*)(Wn + chh * 8192 + gw), (LAS unsigned*)(db + W_OFF + i * 8192), 16, 0, 0); \
            __builtin_amdgcn_global_load_lds((const unsigned*)(Qd + chh * 8192 + gw), (LAS unsigned*)(db + Q_OFF + i * 8192), 16, 0, 0); \
            __builtin_amdgcn_global_load_lds((const unsigned*)(Kd + chh * 8192 + gk), (LAS unsigned*)(db + K_OFF + i * 8192), 16, 0, 0); } \
        { const int r8 = 8 * wv + (lq >> 3), c8 = (lq & 7) ^ ((r8 >> 1) & 7); \
          __builtin_amdgcn_global_load_lds((const unsigned*)(Ai + chh * 4096 + (unsigned)(r8 * 64 + c8 * 8)), (LAS unsigned*)(db + A_OFF), 16, 0, 0); } \
        { const bf16_t* rp = rub + (size_t)(cw ? ((DRY & 4) ? 0 : (nn)) : (zn)) * ru_step; \
          _Pragma("unroll") for (int k = 0; k < 8; ++k) ru[k] = *(const u32x2*)(rp + (k >> 1) * ru_a + (k & 1) * ru_b); } \
        if (cw) gl_next = glast[chh]; } while (0)
#define SCAN_STAGE(nn) do { \
        if (cw) { _Pragma("unroll") for (int mt = 0; mt < 4; ++mt) _Pragma("unroll") for (int ct = 0; ct < 2; ++ct) vn[mt][ct] = (f32x4){bflo(ru[2 * mt + ct][0]), bfhi(ru[2 * mt + ct][0]), bflo(ru[2 * mt + ct][1]), bfhi(ru[2 * mt + ct][1])}; gl = gl_next; } } while (0)
#define SCAN_FINAL(nn) do { const int tq = b * SEQ + (nn) * 64; const LAS float* rd = red + ((nn) & 1) * 256; const LAS unsigned char* ot = lds + OT_OFF + ((nn) & 1) * 16384; \
        _Pragma("unroll") for (int ii = 0; ii < 4; ++ii) { const int row = (tid2 >> 4) + 16 * ii; \
            const float tot = (rd[row] + rd[64 + row]) + (rd[128 + row] + rd[192 + row]); const float rstd = rsqrtf(tot * (1.f / 128.f) + EPS); \
            const u32x4 ov = *(const LAS u32x4*)(ot + row * 256 + ((fcc ^ (2 * ((row >> 2) & 3))) * 16)); const u32x4 zz = {ru[2 * ii][0], ru[2 * ii][1], ru[2 * ii + 1][0], ru[2 * ii + 1][1]}; u32x4 res; \
            const f32x4 g0 = *(const LAS f32x4*)(gainl + 8 * fcc), g1 = *(const LAS f32x4*)(gainl + 8 * fcc + 4); const float fgain[8] = {g0[0], g0[1], g0[2], g0[3], g1[0], g1[1], g1[2], g1[3]}; \
            _Pragma("unroll") for (int e = 0; e < 4; ++e) res[e] = pk2(bflo(ov[e]) * rstd * fgain[2 * e] * silu_f(bflo(zz[e])), bfhi(ov[e]) * rstd * fgain[2 * e + 1] * silu_f(bfhi(zz[e]))); \
            if ((DRY & 1) == 0) *(u32x4*)(O + (size_t)(tq + row) * 1024 + h * 128 + 8 * fcc) = res; else if (res[0] == 0x12345u) O[0] = 1; } } while (0)
    SCAN_GLOAD(0, 0, 0);
    f32x4 vn[4][2]; float gl = 0.f;
    SCAN_STAGE(0);
    for (int n = 0; n < 64; ++n) {
        LAS unsigned char* buf = lds + (n & 1) * BUF;
        asm volatile("s_waitcnt vmcnt(0)" ::: "memory");
        asm volatile("s_waitcnt lgkmcnt(0)" ::: "memory");
        __builtin_amdgcn_s_barrier();
        asm volatile("" ::: "memory");
        if (!cw) SCAN_FINAL(n > 0 ? n - 1 : 0);
        SCAN_GLOAD(n + 1 < 64 ? n + 1 : 63, n, n + 1);
        __builtin_amdgcn_sched_barrier(0);
        if (cw) {
            bf16x8 Sb[4][2];
#pragma unroll
            for (int ks = 0; ks < 4; ++ks) { Sb[ks][0] = pack8(S[2 * ks][0], S[2 * ks + 1][0]); Sb[ks][1] = pack8(S[2 * ks][1], S[2 * ks + 1][1]); }
#pragma unroll
            for (int mt = 0; mt < 4; ++mt)
#pragma unroll
                for (int ks = 0; ks < 4; ++ks) { const bf16x8 a = *(const LAS bf16x8*)(buf + W_OFF + (16 * mt + fr) * 256 + (((4 * ks + fq) ^ fr) * 16));
                    vn[mt][0] = MFMA16(a, Sb[ks][0], vn[mt][0]); vn[mt][1] = MFMA16(a, Sb[ks][1], vn[mt][1]); }
            __builtin_amdgcn_sched_barrier(0);
            bf16x8 vb[2][2];
#pragma unroll
            for (int ct = 0; ct < 2; ++ct) { vb[0][ct] = pack8(vn[0][ct], vn[1][ct]); vb[1][ct] = pack8(vn[2][ct], vn[3][ct]); }
#pragma unroll
            for (int mt = 0; mt < 4; ++mt) { vn[mt][0] = (f32x4){0.f, 0.f, 0.f, 0.f}; vn[mt][1] = (f32x4){0.f, 0.f, 0.f, 0.f};
#pragma unroll
                for (int ks = 0; ks < 4; ++ks) { const bf16x8 a = *(const LAS bf16x8*)(buf + Q_OFF + (16 * mt + fr) * 256 + (((4 * ks + fq) ^ fr) * 16));
                    vn[mt][0] = MFMA16(a, Sb[ks][0], vn[mt][0]); vn[mt][1] = MFMA16(a, Sb[ks][1], vn[mt][1]); }
#pragma unroll
                for (int ks = 0; ks < 2; ++ks) { const bf16x8 a = *(const LAS bf16x8*)(buf + A_OFF + (16 * mt + fr) * 128 + (((4 * ks + fq) ^ (fr >> 1)) * 16));
                    vn[mt][0] = MFMA16(a, vb[ks][0], vn[mt][0]); vn[mt][1] = MFMA16(a, vb[ks][1], vn[mt][1]); } }
            __builtin_amdgcn_sched_barrier(0);
            LAS bf16_t* ot = (LAS bf16_t*)(lds + OT_OFF + (n & 1) * 16384);
#pragma unroll
            for (int mt = 0; mt < 4; ++mt) {
                f32x4 sq = vn[mt][0] * vn[mt][0] + vn[mt][1] * vn[mt][1];
#pragma unroll
                for (int j = 0; j < 4; ++j) { sq[j] = row16_sum(sq[j]);
                    const int row = 16 * mt + 4 * fq + j;
                    ot[row * 128 + ((32 * w4 + fr) ^ (16 * fq))] = f2bf(vn[mt][0][j]);
                    ot[row * 128 + ((32 * w4 + 16 + fr) ^ (16 * fq))] = f2bf(vn[mt][1][j]); }
                if (fr == 0) *(LAS f32x4*)(red + (n & 1) * 256 + w4 * 64 + 16 * mt + 4 * fq) = sq;
            }
                    __builtin_amdgcn_sched_barrier(0);
#pragma unroll
            for (int m8 = 0; m8 < 8; ++m8) { S[m8][0] = S[m8][0] * gl; S[m8][1] = S[m8][1] * gl;
#pragma unroll
                for (int ks = 0; ks < 2; ++ks) { const bf16x8 a = *(const LAS bf16x8*)(buf + K_OFF + (16 * m8 + fr) * 128 + (((4 * ks + fq) ^ (fr >> 1)) * 16));
                    S[m8][0] = MFMA16(a, vb[ks][0], S[m8][0]); S[m8][1] = MFMA16(a, vb[ks][1], S[m8][1]); } }
        }
        SCAN_STAGE(n + 1);
    }
    asm volatile("s_waitcnt vmcnt(0)" ::: "memory");
    __syncthreads();
    if (!cw) SCAN_FINAL(63);
#undef SCAN_FINAL
#undef SCAN_STAGE
#undef SCAN_GLOAD
    __syncthreads();
}

__device__ __forceinline__ void moba_attn_item(const Params& p, LAS unsigned char* lds, int item, bool dry = false) {
    const int tid = threadIdx.x, wv = tid >> 6, lane = tid & 63, fr = lane & 15, fq = lane >> 4;
    const int blk = 15 - (item >> 6), bh = item & 63, b = bh >> 3, h = bh & 7, t0 = b * SEQ + blk * 256;
    constexpr int KT_B = 16384, BUF = 32768;
    LAS float* kml = (LAS float*)(lds + 98304); LAS float* gts = (LAS float*)(lds + 102144); LAS unsigned* sel = (LAS unsigned*)(lds + 118528);
    bf16_t* O = (bf16_t*)(p.ws + WS_O); const bf16_t* kn = (const bf16_t*)p.out; const bf16_t* Vt = (const bf16_t*)p.out + (size_t)T * 512;
    const float* kmean = (const float*)(p.ws + WS_KMEAN) + (size_t)((b * 8 + h) * 16) * 64;
    unsigned kofs[2], vofs[2];
#pragma unroll
    for (int i = 0; i < 2; ++i) { const int pc = wv + 8 * i; const int rk = 8 * pc + (lane >> 3), ck = (lane & 7) ^ ((rk >> 1) & 7); kofs[i] = (unsigned)(rk * 512 + ck * 8);
        const int rv = 4 * pc + (lane >> 4), cv = (lane & 15) ^ (rv & 15); vofs[i] = (unsigned)(rv * 256 + cv * 8); }
    const bf16_t* knh = kn + (size_t)b * SEQ * 512 + h * 64; const bf16_t* vth = Vt + (size_t)((b * 8 + h) * 16) * 16384;
#define ATT_DMA(tix_, par_) do { const int nb_ = (tix_) >> 1, hf_ = (tix_) & 1; LAS unsigned char* db = lds + (par_) * BUF + wv * 1024; \
        _Pragma("unroll") for (int i = 0; i < 2; ++i) { \
            __builtin_amdgcn_global_load_lds((const unsigned*)(knh + (size_t)(nb_ * 256 + hf_ * 128) * 512 + kofs[i]), (LAS unsigned*)(db + i * 8192), 16, 0, 0); \
            __builtin_amdgcn_global_load_lds((const unsigned*)(vth + (size_t)nb_ * 16384 + hf_ * 128 + vofs[i]), (LAS unsigned*)(db + KT_B + i * 8192), 16, 0, 0); } } while (0)
    const int ntiles = 2 * blk + 2;
    ATT_DMA(0, 0); ATT_DMA(1, 1);
    bf16x8 qf[2][2];
#pragma unroll
    for (int nt = 0; nt < 2; ++nt)
#pragma unroll
        for (int ks = 0; ks < 2; ++ks) qf[nt][ks] = *(const bf16x8*)(O + (size_t)(t0 + 32 * wv + 16 * nt + fr) * 1024 + 512 + h * 64 + 32 * ks + 8 * fq);
    if (blk > 3) {
        for (int idx = tid; idx < blk * 64; idx += 512) kml[idx] = kmean[idx];
        __syncthreads();
        {
            const int qi = tid & 255, part = tid >> 8; const bf16_t* src = O + (size_t)(t0 + qi) * 1024 + 512 + h * 64;
            u32x4 qp[8];
#pragma unroll
            for (int c8 = 0; c8 < 8; ++c8) qp[c8] = *(const u32x4*)(src + 8 * c8);
            for (int nb = part; nb < blk; nb += 2) { float s = 0.f;
#pragma unroll
                for (int c8 = 0; c8 < 8; ++c8) { const f32x4 ka = *(const LAS f32x4*)(kml + nb * 64 + 8 * c8), kb = *(const LAS f32x4*)(kml + nb * 64 + 8 * c8 + 4);
                    s += bflo(qp[c8][0]) * ka[0] + bfhi(qp[c8][0]) * ka[1] + bflo(qp[c8][1]) * ka[2] + bfhi(qp[c8][1]) * ka[3]
                       + bflo(qp[c8][2]) * kb[0] + bfhi(qp[c8][2]) * kb[1] + bflo(qp[c8][3]) * kb[2] + bfhi(qp[c8][3]) * kb[3]; }
                gts[qi * 16 + nb] = s; }
        }
        __syncthreads();
        if (tid < 256) {
            float v1 = -INFINITY, v2 = -INFINITY, v3 = -INFINITY; int i1 = 0, i2 = 0, i3 = 0;
            for (int nb = 0; nb < blk; ++nb) { const float g = gts[tid * 16 + nb];
                if (g > v1) { v3 = v2; i3 = i2; v2 = v1; i2 = i1; v1 = g; i1 = nb; }
                else if (g > v2) { v3 = v2; i3 = i2; v2 = g; i2 = nb; }
                else if (g > v3) { v3 = g; i3 = nb; } }
            sel[tid] = (1u << i1) | (1u << i2) | (1u << i3);
        }
    } else { if (tid < 256) sel[tid] = (1u << blk) - 1u; }
    __syncthreads();
    unsigned selm[2]; selm[0] = sel[32 * wv + fr]; selm[1] = sel[32 * wv + 16 + fr];
    float lrun[2] = {0.f, 0.f};
    const float mref = ((const float*)(p.ws + WS_CTR))[32];
    f32x4 oacc[4][2];
#pragma unroll
    for (int dt = 0; dt < 4; ++dt) { oacc[dt][0] = (f32x4){0.f, 0.f, 0.f, 0.f}; oacc[dt][1] = (f32x4){0.f, 0.f, 0.f, 0.f}; }
    int bcur = 0;
    for (int tix = 0; tix < ntiles; ++tix) {
        LAS unsigned char* buf = lds + bcur * BUF;
        asm volatile("s_waitcnt vmcnt(4)" ::: "memory");
        __builtin_amdgcn_s_barrier();
        asm volatile("" ::: "memory");
        { const int nx = tix + 2 < ntiles ? tix + 2 : ntiles - 1; const int bn = bcur == 0 ? 2 : bcur - 1;
          ATT_DMA(nx, bn); }
        const int nb = tix >> 1, half = tix & 1; const bool own = (nb == blk);
        bool active;
        if (own) active = (128 * half <= 32 * wv + 31);
        else active = __any((int)(((selm[0] | selm[1]) >> nb) & 1u)) != 0;
        if (active) {
            f32x4 s[8][2];
#pragma unroll
            for (int kt = 0; kt < 8; ++kt) {
                const bf16x8 k0 = *(const LAS bf16x8*)(buf + (16 * kt + fr) * 128 + ((fq ^ (fr >> 1)) * 16));
                const bf16x8 k1 = *(const LAS bf16x8*)(buf + (16 * kt + fr) * 128 + (((4 + fq) ^ (fr >> 1)) * 16));
#pragma unroll
                for (int nt = 0; nt < 2; ++nt) { f32x4 a = {0.f, 0.f, 0.f, 0.f}; a = MFMA16(k0, qf[nt][0], a); a = MFMA16(k1, qf[nt][1], a); s[kt][nt] = a; }
            }
            constexpr float SC = 0.18033688011112042f;
            if (own) {
                asm volatile("" ::: "memory");
#pragma unroll
                for (int nt = 0; nt < 2; ++nt) { const int qloc = 32 * wv + 16 * nt + fr - 128 * half - 4 * fq;
#pragma unroll
                    for (int kt = 0; kt < 8; ++kt)
#pragma unroll
                        for (int j = 0; j < 4; ++j) s[kt][nt][j] = (16 * kt + j <= qloc) ? s[kt][nt][j] : -INFINITY; }
            }
#pragma unroll
            for (int nt = 0; nt < 2; ++nt) {
                const bool colsel = own || (((selm[nt] >> nb) & 1u) != 0u);
                const float mneg = colsel ? -mref : -INFINITY;
                float ls = 0.f;
#pragma unroll
                for (int kt = 0; kt < 8; ++kt)
#pragma unroll
                    for (int j = 0; j < 4; ++j) { const float pv = __builtin_amdgcn_exp2f(__builtin_fmaf(s[kt][nt][j], SC, mneg)); s[kt][nt][j] = pv; ls += pv; }
                lrun[nt] += ls;
            }
#pragma unroll
            for (int ks = 0; ks < 4; ++ks) {
                const bf16x8 pb0 = pack8(s[2 * ks][0], s[2 * ks + 1][0]), pb1 = pack8(s[2 * ks][1], s[2 * ks + 1][1]);
#pragma unroll
                for (int dt = 0; dt < 4; ++dt) { const bf16x8 vf = *(const LAS bf16x8*)(buf + KT_B + (16 * dt + fr) * 256 + (((4 * ks + fq) ^ fr) * 16));
                    oacc[dt][0] = MFMA16(vf, pb0, oacc[dt][0]); oacc[dt][1] = MFMA16(vf, pb1, oacc[dt][1]); }
            }
        }
        bcur = bcur == 2 ? 0 : bcur + 1;
    }
#undef ATT_DMA
    asm volatile("s_waitcnt vmcnt(0)" ::: "memory");
#pragma unroll
    for (int nt = 0; nt < 2; ++nt) {
        float lt = lrun[nt]; lt += __shfl_xor(lt, 16); lt += __shfl_xor(lt, 32); const float inv = 1.f / lt;
        bf16_t* dst = (dry ? (bf16_t*)(p.ws + WS_END) + (size_t)(32 * wv + 16 * nt + fr) * 1024 : O + (size_t)(t0 + 32 * wv + 16 * nt + fr) * 1024) + 512 + h * 64 + 4 * fq;
#pragma unroll
        for (int dt = 0; dt < 4; ++dt) { u32x2 w = {pk2(oacc[dt][nt][0] * inv, oacc[dt][nt][1] * inv), pk2(oacc[dt][nt][2] * inv, oacc[dt][nt][3] * inv)}; *(u32x2*)(dst + 16 * dt) = w; }
    }
    __syncthreads();
}

__device__ __forceinline__ void grid_barrier(unsigned* ctl, unsigned gen) {
    __syncthreads();
    if (threadIdx.x == 0) {
        __builtin_amdgcn_fence(__ATOMIC_RELEASE, "agent");
        const unsigned G = gridDim.x;
        if ((G & 7u) == 0u) {
            const unsigned gs = G >> 3, g = blockIdx.x & 7u;
            const unsigned old = __hip_atomic_fetch_add(ctl + 128 + 32 * g, 1u, __ATOMIC_RELAXED, __HIP_MEMORY_SCOPE_AGENT);
            if (old + 1u == gs * gen) {
                __builtin_amdgcn_fence(__ATOMIC_ACQ_REL, "agent");
                __hip_atomic_fetch_add(ctl + 64, 1u, __ATOMIC_RELAXED, __HIP_MEMORY_SCOPE_AGENT);
            }
            while (__hip_atomic_load(ctl + 64, __ATOMIC_RELAXED, __HIP_MEMORY_SCOPE_AGENT) < 8u * gen) __builtin_amdgcn_s_sleep(1);
        } else {
            __hip_atomic_fetch_add(ctl + 16, 1u, __ATOMIC_RELAXED, __HIP_MEMORY_SCOPE_AGENT);
            while (__hip_atomic_load(ctl + 16, __ATOMIC_RELAXED, __HIP_MEMORY_SCOPE_AGENT) < G * gen) __builtin_amdgcn_s_sleep(2);
        }
        __builtin_amdgcn_fence(__ATOMIC_ACQUIRE, "agent");
    }
    __syncthreads();
}
__device__ __forceinline__ void fill_row_scales(const pg8::StaticOrder& S, const float* ss, LAS float* rt) {
    const int tid = threadIdx.x;
    if (tid < 256) {
        float t[12];
#pragma unroll
        for (int i = 0; i < 12; ++i) { pg8::Unit u; t[i] = S.next(i, u) ? ss[u.pm * 256 + tid] : 1024.f; }
#pragma unroll
        for (int i = 0; i < 12; ++i) rt[i * 256 + tid] = rsqrtf(t[i] * (1.f / 1024.f) + EPS);
    }
    __syncthreads();
}
template <int PH>
__device__ __forceinline__ void run_phase(const Params& p, LAS unsigned char* lds) {
    unsigned char* ws = p.ws;
    if constexpr (PH == 0) { if constexpr (PH_MASK & 1) { phase_prep(p, lds); if constexpr (REP & 1) { __syncthreads(); phase_prep(p, lds); } } }
    else if constexpr (PH == 1 || PH == 7) {
        if constexpr (PH_MASK & 2) {
        pg8::Gemm g{(const bf16_t*)(ws + WS_X), (const bf16_t*)(ws + (PH == 1 ? WS_WGU1 : WS_WGU2)), T, 5632, 1024};
        pg8::StaticOrder S; S.init(g.M, g.N, (int)gridDim.x, (int)blockIdx.x);
        EpiSwiGLU<(PH == 7)> E{(bf16_t*)(ws + WS_R1), (const LAS float*)(lds + RT_OFF)};
        if constexpr (PH == 7) fill_row_scales(S, (const float*)(ws + WS_SS3), (LAS float*)(lds + RT_OFF));
        pg8::gemm_phase(lds, g, S, E);
        if constexpr ((REP & 2) && PH == 1) pg8::gemm_phase(lds, g, S, E); }
    } else if constexpr (PH == 2 || PH == 6 || PH == 8) {
        if constexpr (PH_MASK & 4) {
        bf16_t* xb = (bf16_t*)(ws + WS_X);
        if constexpr (PH == 2) { pg8::Gemm g{(const bf16_t*)(ws + WS_R1), (const bf16_t*)(ws + WS_WD1), T, 1024, FF}; EpiResid<0> E{p.in[I_X], nullptr, nullptr, xb, (float*)(ws + WS_SS2), 0.5f};
            pg8::StaticOrder S; S.init(g.M, g.N, (int)gridDim.x, (int)blockIdx.x); pg8::gemm_phase(lds, g, S, E);
            if constexpr (REP & 4) { E.ss = nullptr; pg8::gemm_phase(lds, g, S, E); } }
        else if constexpr (PH == 6) { pg8::Gemm g{(const bf16_t*)(ws + WS_O), (const bf16_t*)(ws + WS_WOUT), T, 1024, 1024}; EpiResid<1> E{nullptr, xb, nullptr, xb, (float*)(ws + WS_SS3), 1.0f};
            pg8::StaticOrder S; S.init(g.M, g.N, (int)gridDim.x, (int)blockIdx.x); pg8::gemm_phase(lds, g, S, E); }
        else { pg8::Gemm g{(const bf16_t*)(ws + WS_R1), (const bf16_t*)(ws + WS_WD2), T, 1024, FF}; EpiResid<2> E{nullptr, xb, p.out, nullptr, nullptr, 0.5f};
            pg8::StaticOrder S; S.init(g.M, g.N, (int)gridDim.x, (int)blockIdx.x); pg8::gemm_phase(lds, g, S, E); }
        }
    } else if constexpr (PH == 3) {
        if constexpr (PH_MASK & 8) {
        ab_rows(p);
        pg8::Gemm g{(const bf16_t*)(ws + WS_X), (const bf16_t*)(ws + WS_WIN), T, 3584, 1024};
        pg8::StaticOrder S; S.init(g.M, g.N, (int)gridDim.x, (int)blockIdx.x);
        EpiInProj E{(bf16_t*)(ws + WS_R1), (bf16_t*)(ws + WS_O), (const LAS float*)(lds + RT_OFF)};
        fill_row_scales(S, (const float*)(ws + WS_SS2), (LAS float*)(lds + RT_OFF));
        pg8::gemm_phase(lds, g, S, E);
        if constexpr (REP & 8) { ab_rows(p); pg8::gemm_phase(lds, g, S, E); } }
    } else if constexpr (PH == 4) {
        if constexpr (PH_MASK & 16) for (int rep = 0; rep < ((REP & 16) ? 2 : 1); ++rep) for (int it = blockIdx.x; it < 1024; it += gridDim.x) g1_item(p, lds, it);
        if constexpr (PH_MASK & 32) for (int rep = 0; rep < ((REP & 32) ? 2 : 1); ++rep) for (int it = blockIdx.x; it < 1024; it += gridDim.x) moba_prep_item(p, lds, it, (REP & 32) && rep == 0);
    } else if constexpr (PH == 5) {
        if constexpr (REP & 128) { LAS int* slot = (LAS int*)(lds + 119616); unsigned* ctr = (unsigned*)(ws + WS_CTR) + 1;
            for (;;) { if (threadIdx.x == 0) *slot = (int)atomicAdd(ctr, 1u); __syncthreads(); const int item = *slot; __syncthreads(); if (item >= 1024) break; moba_attn_item(p, lds, item, true); } }
        if constexpr (REP & 64) for (int bh = blockIdx.x; bh < 32; bh += gridDim.x) gdn_scan<(REP >> 8) & 7>(p, lds, bh);
        if constexpr (PH_MASK & 64) for (int bh = blockIdx.x; bh < 32; bh += gridDim.x) gdn_scan<0>(p, lds, bh);
        if constexpr (PH_MASK & 128) {
        LAS int* slot = (LAS int*)(lds + 119616);
        unsigned* ctr = (unsigned*)(ws + WS_CTR);
        const int nstat = (int)gridDim.x > 32 ? (int)gridDim.x - 32 : 0;
        bool first = (int)blockIdx.x >= 32;
        for (;;) {
            if (threadIdx.x == 0) *slot = first ? (int)blockIdx.x - 32 : nstat + (int)atomicAdd(ctr, 1u);
            first = false;
            __syncthreads();
            const int item = *slot;
            __syncthreads();
            if (item >= 1024) break;
            moba_attn_item(p, lds, item);
        } }
    }
}
__global__ void __launch_bounds__(512, 2) hymba_mega(Params p) {
    extern __shared__ __attribute__((aligned(16))) unsigned char shm[];
    LAS unsigned char* lds = (LAS unsigned char*)shm;
    cg::grid_group grid = cg::this_grid();
    const int lo = p.ph_lo, hi = p.ph_hi;
    unsigned* bar = (unsigned*)(p.ws + WS_CTR);
    if (hi > 1000) grid.sync();
#define RUN_PH(k) do { if (lo <= (k) && (k) < hi) { run_phase<k>(p, lds); if ((k) + 1 < hi) grid_barrier(bar, (unsigned)((k) + 1 - lo)); } } while (0)
    RUN_PH(0); RUN_PH(1); RUN_PH(2); RUN_PH(3); RUN_PH(4); RUN_PH(5); RUN_PH(6); RUN_PH(7); RUN_PH(8);
#undef RUN_PH
}

extern "C" void kernel_launch(void* const* d_in, const int* in_sizes, int n_in, void* d_out, int out_size, void* d_ws, size_t ws_size, hipStream_t stream) {
    static int grid_blocks = 0;
    if (grid_blocks == 0) {
        if (n_in != 18 || in_sizes[0] != T * DM || out_size != T * DM || ws_size < WS_END) {
            fprintf(stderr, "kernel_launch: unexpected shapes (n_in %d, in0 %d, out %d, ws %zu, need %zu)\n", n_in, n_in > 0 ? in_sizes[0] : -1, out_size, ws_size, (size_t)WS_END);
            grid_blocks = -1; return; }
        int dev = 0, cus = 0, per_cu = 0;
        hipGetDevice(&dev);
        hipDeviceGetAttribute(&cus, hipDeviceAttributeMultiprocessorCount, dev);
        if (hipFuncSetAttribute((const void*)hymba_mega, hipFuncAttributeMaxDynamicSharedMemorySize, LDS_BYTES) != hipSuccess) { fprintf(stderr, "kernel_launch: hipFuncSetAttribute failed\n"); grid_blocks = -1; return; }
        if (hipOccupancyMaxActiveBlocksPerMultiprocessor(&per_cu, (const void*)hymba_mega, 512, LDS_BYTES) != hipSuccess || per_cu < 1) { fprintf(stderr, "kernel_launch: occupancy query says %d\n", per_cu); (void)hipGetLastError(); per_cu = 1; }
        grid_blocks = cus * (per_cu > 1 ? 1 : per_cu);
        if (grid_blocks < 1) grid_blocks = 256;
    }
    if (grid_blocks < 0) return;
    if (hipMemsetAsync((char*)d_ws + WS_CTR, 0, 4096, stream) != hipSuccess) { fprintf(stderr, "kernel_launch: hipMemsetAsync failed\n"); return; }
    Params p{};
    for (int i = 0; i < 18; ++i) p.in[i] = (const float*)d_in[i];
    p.out = (float*)d_out; p.ws = (unsigned char*)d_ws;
#if N_LAUNCH_MODE == 1
    p.ph_lo = 0; p.ph_hi = 9;
    void* args[] = {&p};
    hipError_t e = hipLaunchCooperativeKernel((const void*)hymba_mega, dim3(grid_blocks), dim3(512), args, LDS_BYTES, stream);
    if (e != hipSuccess) fprintf(stderr, "cooperative launch failed: %s (grid %d)\n", hipGetErrorString(e), grid_blocks);
#else
    for (int ph = 0; ph < 9; ++ph) { p.ph_lo = ph; p.ph_hi = ph + 1; hipLaunchKernelGGL(hymba_mega, dim3(grid_blocks), dim3(512), LDS_BYTES, stream, p); }
#endif
}
```

```cpp
#include <hip/hip_runtime.h>
#include <hip/hip_cooperative_groups.h>
#include <cstdio>
namespace cg = cooperative_groups;

#define LAS __attribute__((address_space(3)))
typedef unsigned short bf16_t;
typedef short bf16x8 __attribute__((ext_vector_type(8)));
typedef float f32x4 __attribute__((ext_vector_type(4)));
typedef float f32x2 __attribute__((ext_vector_type(2)));
typedef unsigned u32x4 __attribute__((ext_vector_type(4)));
typedef unsigned u32x2 __attribute__((ext_vector_type(2)));
typedef __bf16 bf16x2_t __attribute__((ext_vector_type(2)));

#ifndef PH_MASK
#define PH_MASK 0xfff
#endif
#ifndef REP
#define REP 0
#endif
#ifndef N_LAUNCH_MODE
#define N_LAUNCH_MODE 1
#endif

constexpr int T = 32768, DM = 1024, FF = 2816, SEQ = 4096;
constexpr float EPS = 1e-6f;
constexpr int LDS_BYTES = 159744;
constexpr int PA_LD = 2560;
constexpr size_t WS_X = 0;
constexpr size_t WS_R1 = WS_X + (size_t)T * 1024 * 2;
constexpr size_t WS_O = WS_R1 + (size_t)T * FF * 2;
constexpr size_t WS_WN = WS_O + (size_t)T * 1024 * 2;
constexpr size_t WS_QD = WS_WN + (size_t)2048 * 8192 * 2;
constexpr size_t WS_KD = WS_QD + (size_t)2048 * 8192 * 2;
constexpr size_t WS_US = WS_KD + (size_t)2048 * 8192 * 2;
constexpr size_t WS_AI = WS_US + (size_t)2048 * 8192 * 2;
constexpr size_t WS_WGU1 = WS_AI + (size_t)2048 * 4096 * 2;
constexpr size_t WS_WD1 = WS_WGU1 + (size_t)5632 * 1024 * 2;
constexpr size_t WS_WGU2 = WS_WD1 + (size_t)1024 * FF * 2;
constexpr size_t WS_WD2 = WS_WGU2 + (size_t)5632 * 1024 * 2;
constexpr size_t WS_WIN = WS_WD2 + (size_t)1024 * FF * 2;
constexpr size_t WS_WOUT = WS_WIN + (size_t)3584 * 1024 * 2;
constexpr size_t WS_WAB = WS_WOUT + (size_t)1024 * 1024 * 2;
constexpr size_t WS_SS1 = WS_WAB + 16 * 1024 * 2;
constexpr size_t WS_SS2 = WS_SS1 + (size_t)T * 4;
constexpr size_t WS_SS3 = WS_SS2 + (size_t)T * 4;
constexpr size_t WS_AB = WS_SS3 + (size_t)T * 4;
constexpr size_t WS_KMEAN = WS_AB + (size_t)T * 8 * 4;
constexpr size_t WS_GLAST = WS_KMEAN + (size_t)8 * 8 * 16 * 64 * 4;
constexpr size_t WS_CTR = WS_GLAST + 2048 * 4;
constexpr size_t WS_END = WS_CTR + 4096;
constexpr size_t X_VT = (size_t)T * 512 * 2;

struct Params {
    const float* in[18];
    float* out;
    unsigned char* ws;
    int ph_lo, ph_hi;
};
enum { I_X = 0, I_F1N, I_F1G, I_F1U, I_F1D, I_MIXN, I_WIN, I_CONV, I_ALOG, I_DTB, I_ONORM, I_QNORM, I_KNORM, I_WOUT, I_F2N, I_F2G, I_F2U, I_F2D };

__device__ __forceinline__ unsigned pk2(float a, float b) { f32x2 v = {a, b}; bf16x2_t r = __builtin_convertvector(v, bf16x2_t); return __builtin_bit_cast(unsigned, r); }
__device__ __forceinline__ float bf2f(bf16_t h) { return __uint_as_float((unsigned)h << 16); }
__device__ __forceinline__ float bflo(unsigned w) { return __uint_as_float(w << 16); }
__device__ __forceinline__ float bfhi(unsigned w) { return __uint_as_float(w & 0xffff0000u); }
__device__ __forceinline__ bf16_t f2bf(float a) { return (bf16_t)(pk2(a, 0.f) & 0xffffu); }
__device__ __forceinline__ float fast_sigmoid(float g) { return __builtin_amdgcn_rcpf(1.f + __builtin_amdgcn_exp2f(-1.44269504f * g)); }
__device__ __forceinline__ float silu_f(float g) { return g * fast_sigmoid(g); }
__device__ __forceinline__ bf16x8 pack8(const f32x4& a, const f32x4& b) { u32x4 p = {pk2(a[0], a[1]), pk2(a[2], a[3]), pk2(b[0], b[1]), pk2(b[2], b[3])}; return __builtin_bit_cast(bf16x8, p); }
#define MFMA16(a, b, c) __builtin_amdgcn_mfma_f32_16x16x32_bf16((a), (b), (c), 0, 0, 0)
__device__ __forceinline__ int pos32(int a) { return 8 * ((a >> 2) & 3) + 4 * (a >> 4) + (a & 3); }
__device__ __forceinline__ int act32(int p) { return 16 * ((p >> 2) & 1) + 4 * (p >> 3) + (p & 3); }

namespace pg8 {
constexpr int BM = 256, BK = 64, HALF = 128, HTB = HALF * BK * 2, STAGE_BYTES = 8 * HTB, NXCD = 8, WGM = 8;
__host__ __device__ __forceinline__ int lds_byte(int r, int c) { const int st = (r >> 4) * 2 + (c >> 5), rr = r & 15, cc = c & 31, ob = rr * 64 + cc * 2; return st * 1024 + (ob ^ (((ob >> 9) & 1) << 5)); }
__host__ __device__ __forceinline__ void stage_rc(int b, int& R, int& C) { const int st = b / 1024, sb = b % 1024, swz = sb ^ (((sb >> 9) & 1) << 5); R = (st >> 1) * 16 + swz / 64; C = (st & 1) * 32 + (swz % 64) / 2; }
__host__ __device__ __forceinline__ int perm32(int rho) { const int n = rho >> 4, i = rho & 15; return 8 * (i >> 2) + 4 * n + (i & 3); }
struct Unit { int pm, pn; };
struct Gemm { const bf16_t* A; const bf16_t* Bt; int M, N, K; };
struct StaticOrder {
    int nM, nN, nwg, G, c;
    __device__ void init(int M, int N, int G_, int c_) { nM = M / BM; nN = N / BM; nwg = nM * nN; G = G_; c = c_; }
    __device__ bool next(int i, Unit& u) const {
        const long L = (long)i * G + c; if (L >= nwg) return false;
        int wgid = (int)L; { const int q = nwg / NXCD, r = nwg % NXCD, xcd = wgid % NXCD, off = wgid / NXCD; wgid = (xcd < r ? xcd * (q + 1) : r * (q + 1) + (xcd - r) * q) + off; }
        const int nig = WGM * nN, gid = wgid / nig, fm = gid * WGM, gsz = (nM - fm) < WGM ? (nM - fm) : WGM;
        u.pm = fm + ((wgid % nig) % gsz); u.pn = (wgid % nig) / gsz; return true;
    }
};
template <class Epi>
__device__ __forceinline__ void gemm_phase(LAS unsigned char* lds, const Gemm g, const StaticOrder& S, const Epi& E) {
    const int tid = threadIdx.x, wid = __builtin_amdgcn_readfirstlane(tid >> 6), lane = tid & 63, wr = wid >> 2, wc = wid & 3, fr = lane & 15, fq = lane >> 4;
    const int K = g.K, nt = K / BK;
    unsigned voffA[2], voffB[2];
#pragma unroll
    for (int i = 0; i < 2; ++i) { int R, C; stage_rc(tid * 16 + i * 8192, R, C); const int Rb = (R & ~31) + perm32(R & 31);
        voffA[i] = (unsigned)(R * K + C) * 2u; voffB[i] = (unsigned)(Rb * K + C) * 2u; }
    const size_t kstep = (size_t)(BK * 2);
    const size_t hstep = (size_t)HALF * K * 2;
    const size_t tstep = 2 * hstep;
    const unsigned ldsw = (unsigned)wid * 1024u;
    const int aoff = lds_byte(wr * 64 + fr, fq * 8), boff = lds_byte(wc * 32 + fr, fq * 8);
#define PG8_SA(b, h) (((b) * 2 + (h)) * HTB)
#define PG8_SB(b, h) ((4 + (b) * 2 + (h)) * HTB)
#define PG8_STAGE(bufoff, gbase, voff) do { _Pragma("unroll") for (int _i = 0; _i < 2; ++_i) \
        __builtin_amdgcn_global_load_lds((const unsigned*)((const char*)(gbase) + (voff)[_i]), (LAS unsigned*)(lds + (bufoff) + ldsw + _i * 8192), 16, 0, 0); } while (0)
#define PG8_LDA(dst, b, h) do { _Pragma("unroll") for (int m = 0; m < 4; ++m) _Pragma("unroll") for (int k = 0; k < 2; ++k) dst[m][k] = *(const LAS bf16x8*)(lds + PG8_SA(b, h) + aoff + m * 2048 + k * 1024); } while (0)
#define PG8_LDB(dst, b, h) do { _Pragma("unroll") for (int n = 0; n < 2; ++n) _Pragma("unroll") for (int k = 0; k < 2; ++k) dst[n][k] = *(const LAS bf16x8*)(lds + PG8_SB(b, h) + boff + n * 2048 + k * 1024); } while (0)
#define PG8_MMA(ai, bj, At, Bt) do { __builtin_amdgcn_s_setprio(1); _Pragma("unroll") for (int m = 0; m < 4; ++m) _Pragma("unroll") for (int n = 0; n < 2; ++n) _Pragma("unroll") for (int k = 0; k < 2; ++k) \
        acc[ai][bj][m][n] = __builtin_amdgcn_mfma_f32_16x16x32_bf16(Bt[n][k], At[m][k], acc[ai][bj][m][n], 0, 0, 0); __builtin_amdgcn_s_setprio(0); } while (0)
#define PG8_WAIT_V(n) asm volatile("s_waitcnt vmcnt(" #n ")" ::: "memory")
#define PG8_WAIT_L(n) asm volatile("s_waitcnt lgkmcnt(" #n ")" ::: "memory")
#define PG8_BAR __builtin_amdgcn_s_barrier()
#define PG8_SCHED __builtin_amdgcn_sched_barrier(0)
    Unit cur, nxt; int ui = 0;
    if (!S.next(0, cur)) return;
    f32x4 acc[2][2][4][2];
#pragma unroll
    for (int a = 0; a < 2; ++a)
#pragma unroll
        for (int b = 0; b < 2; ++b)
#pragma unroll
            for (int m = 0; m < 4; ++m)
#pragma unroll
                for (int n = 0; n < 2; ++n) acc[a][b][m][n] = (f32x4){0.f, 0.f, 0.f, 0.f};
    bf16x8 At[4][2], B0[2][2], B1[2][2];
    const char* cA = (const char*)g.A + (size_t)cur.pm * tstep; const char* cB = (const char*)g.Bt + (size_t)cur.pn * tstep;
    PG8_STAGE(PG8_SB(0, 0), cB, voffB); PG8_STAGE(PG8_SA(0, 0), cA, voffA); PG8_STAGE(PG8_SB(0, 1), cB + hstep, voffB); PG8_STAGE(PG8_SA(0, 1), cA + hstep, voffA);
    if (wr == 1) PG8_BAR;
    PG8_WAIT_V(4); PG8_BAR;
    PG8_STAGE(PG8_SB(1, 0), cB + kstep, voffB); PG8_STAGE(PG8_SA(1, 0), cA + kstep, voffA); PG8_STAGE(PG8_SB(1, 1), cB + hstep + kstep, voffB);
    PG8_WAIT_V(6); PG8_BAR;
    for (;;) {
        const bool has_next = S.next(ui + 1, nxt);
        const char* nA = has_next ? (const char*)g.A + (size_t)nxt.pm * tstep : cA; const char* nB = has_next ? (const char*)g.Bt + (size_t)nxt.pn * tstep : cB;
        for (int t = 0; t < nt; t += 2) {
            const bool last = (t == nt - 2);
            const char* a1 = cA + (size_t)(t + 1) * kstep;
            const char* a2 = last ? nA : cA + (size_t)(t + 2) * kstep; const char* b2 = last ? nB : cB + (size_t)(t + 2) * kstep;
            const char* a3 = a2 + kstep; const char* b3 = b2 + kstep;
            PG8_LDB(B0, 0, 0); PG8_SCHED; PG8_LDA(At, 0, 0); PG8_STAGE(PG8_SA(1, 1), a1 + hstep, voffA);
            PG8_WAIT_L(8); PG8_BAR; PG8_WAIT_L(0); PG8_MMA(0, 0, At, B0); PG8_BAR; PG8_SCHED;
            PG8_LDB(B1, 0, 1); PG8_STAGE(PG8_SB(0, 0), b2, voffB);
            PG8_BAR; PG8_WAIT_L(0); PG8_MMA(0, 1, At, B1); PG8_BAR;
            PG8_LDA(At, 0, 1); PG8_STAGE(PG8_SA(0, 0), a2, voffA);
            PG8_BAR; PG8_WAIT_L(0); PG8_MMA(1, 0, At, B0); PG8_BAR; PG8_SCHED;
            PG8_STAGE(PG8_SB(0, 1), b2 + hstep, voffB);
            PG8_WAIT_V(6); PG8_BAR; PG8_MMA(1, 1, At, B1); PG8_BAR;
            PG8_LDB(B0, 1, 0); PG8_SCHED; PG8_LDA(At, 1, 0); PG8_STAGE(PG8_SA(0, 1), a2 + hstep, voffA);
            PG8_WAIT_L(8); PG8_BAR; PG8_WAIT_L(0); PG8_MMA(0, 0, At, B0); PG8_BAR; PG8_SCHED;
            PG8_LDB(B1, 1, 1); PG8_STAGE(PG8_SB(1, 0), b3, voffB);
            PG8_BAR; PG8_WAIT_L(0); PG8_MMA(0, 1, At, B1); PG8_BAR;
            PG8_LDA(At, 1, 1); PG8_STAGE(PG8_SA(1, 0), a3, voffA);
            PG8_BAR; PG8_WAIT_L(0); PG8_MMA(1, 0, At, B0); PG8_BAR; PG8_SCHED;
            PG8_STAGE(PG8_SB(1, 1), b3 + hstep, voffB);
            PG8_WAIT_V(6); PG8_BAR; PG8_MMA(1, 1, At, B1); PG8_BAR;
        }
        E(acc, cur, ui, wr, wc, fr, fq);
        if (!has_next) break;
#pragma unroll
        for (int a = 0; a < 2; ++a)
#pragma unroll
            for (int b = 0; b < 2; ++b)
#pragma unroll
                for (int m = 0; m < 4; ++m)
#pragma unroll
                    for (int n = 0; n < 2; ++n) acc[a][b][m][n] = (f32x4){0.f, 0.f, 0.f, 0.f};
        cur = nxt; cA = nA; cB = nB; ++ui;
    }
    PG8_WAIT_V(0);
    if (wr == 0) PG8_BAR;
    PG8_BAR;
#undef PG8_SA
#undef PG8_SB
#undef PG8_STAGE
#undef PG8_LDA
#undef PG8_LDB
#undef PG8_MMA
#undef PG8_WAIT_V
#undef PG8_WAIT_L
#undef PG8_BAR
#undef PG8_SCHED
}
}
using pg8::Unit;

constexpr int RT_OFF = 131072;
template <bool SCALE> struct EpiSwiGLU {
    bf16_t* act; const LAS float* rt;
    __device__ __forceinline__ void operator()(const f32x4 (&acc)[2][2][4][2], const Unit& u, int ui, int wr, int wc, int fr, int fq) const {
        const int row0 = u.pm * 256 + wr * 64 + fr, col0 = u.pn * 128 + wc * 32 + 8 * fq; const LAS float* rtu = rt + ui * 256 + wr * 64 + fr;
        float rs[2][4];
#pragma unroll
        for (int ai = 0; ai < 2; ++ai)
#pragma unroll
            for (int m = 0; m < 4; ++m) rs[ai][m] = SCALE ? rtu[ai * 128 + m * 16] : 1.f;
#pragma unroll
        for (int ai = 0; ai < 2; ++ai)
#pragma unroll
            for (int m = 0; m < 4; ++m) {
                const int row = row0 + ai * 128 + m * 16;
                const float r = rs[ai][m];
                float hv[8];
#pragma unroll
                for (int n = 0; n < 2; ++n)
#pragma unroll
                    for (int j = 0; j < 4; ++j) { const float g = acc[ai][0][m][n][j] * r, up = acc[ai][1][m][n][j] * r; hv[4 * n + j] = silu_f(g) * up; }
                u32x4 w = {pk2(hv[0], hv[1]), pk2(hv[2], hv[3]), pk2(hv[4], hv[5]), pk2(hv[6], hv[7])};
                *(u32x4*)(act + (size_t)row * FF + col0) = w;
            }
    }
};
template <int MODE> struct EpiResid {
    const float* residf; const bf16_t* residb; float* outf; bf16_t* outb; float* ss; float scale;
    __device__ __forceinline__ void operator()(const f32x4 (&acc)[2][2][4][2], const Unit& u, int ui, int wr, int wc, int fr, int fq) const {
        const int row0 = u.pm * 256 + wr * 64 + fr, col0 = u.pn * 256 + wc * 32 + 8 * fq;
#pragma unroll
        for (int ai = 0; ai < 2; ++ai) {
            f32x4 rf[MODE == 0 ? 4 : 1][2][2]; u32x4 rb[MODE == 0 ? 1 : 4][2];
#pragma unroll
            for (int m = 0; m < 4; ++m)
#pragma unroll
                for (int bj = 0; bj < 2; ++bj) { const size_t off = (size_t)(row0 + ai * 128 + m * 16) * 1024 + col0 + bj * 128;
                    if constexpr (MODE == 0) { rf[m][bj][0] = *(const f32x4*)(residf + off); rf[m][bj][1] = *(const f32x4*)(residf + off + 4); }
                    else rb[m][bj] = *(const u32x4*)(residb + off); }
#pragma unroll
            for (int m = 0; m < 4; ++m) {
                const int row = row0 + ai * 128 + m * 16; float sq = 0.f;
#pragma unroll
                for (int bj = 0; bj < 2; ++bj) {
                    const size_t off = (size_t)row * 1024 + col0 + bj * 128;
                    f32x4 r0, r1;
                    if constexpr (MODE == 0) { r0 = rf[m][bj][0]; r1 = rf[m][bj][1]; }
                    else { const u32x4 q = rb[m][bj]; r0 = (f32x4){bflo(q[0]), bfhi(q[0]), bflo(q[1]), bfhi(q[1])}; r1 = (f32x4){bflo(q[2]), bfhi(q[2]), bflo(q[3]), bfhi(q[3])}; }
                    const f32x4 v0 = r0 + scale * acc[ai][bj][m][0], v1 = r1 + scale * acc[ai][bj][m][1];
                    if constexpr (MODE == 2) { *(f32x4*)(outf + off) = v0; *(f32x4*)(outf + off + 4) = v1; }
                    else { u32x4 w = {pk2(v0[0], v0[1]), pk2(v0[2], v0[3]), pk2(v1[0], v1[1]), pk2(v1[2], v1[3])}; *(u32x4*)(outb + off) = w;
                        sq += v0[0] * v0[0] + v0[1] * v0[1] + v0[2] * v0[2] + v0[3] * v0[3] + v1[0] * v1[0] + v1[1] * v1[1] + v1[2] * v1[2] + v1[3] * v1[3]; }
                }
                if constexpr (MODE != 2) { if (ss) { sq += __shfl_xor(sq, 16); sq += __shfl_xor(sq, 32); if (fq == 0) unsafeAtomicAdd(ss + row, sq); } }
            }
        }
    }
};
struct EpiInProj {
    bf16_t* Pa; bf16_t* Pb; const LAS float* rt;
    __device__ __forceinline__ void operator()(const f32x4 (&acc)[2][2][4][2], const Unit& u, int ui, int wr, int wc, int fr, int fq) const {
        const int row0 = u.pm * 256 + wr * 64 + fr, col0 = u.pn * 256 + wc * 32 + 8 * fq;
        const bool toA = u.pn < 10; const LAS float* rtu = rt + ui * 256 + wr * 64 + fr;
#pragma unroll
        for (int ai = 0; ai < 2; ++ai)
#pragma unroll
            for (int m = 0; m < 4; ++m) {
                const int row = row0 + ai * 128 + m * 16;
                const float r = rtu[ai * 128 + m * 16];
#pragma unroll
                for (int bj = 0; bj < 2; ++bj) {
                    const f32x4 v0 = acc[ai][bj][m][0] * r, v1 = acc[ai][bj][m][1] * r;
                    u32x4 w = {pk2(v0[0], v0[1]), pk2(v0[2], v0[3]), pk2(v1[0], v1[1]), pk2(v1[2], v1[3])};
                    const int col = col0 + bj * 128;
                    bf16_t* dst = toA ? Pa + (size_t)row * PA_LD + col : Pb + (size_t)row * 1024 + (col - 2560);
                    *(u32x4*)dst = w;
                }
            }
    }
};

__device__ __forceinline__ float wave_sum(float v) {
#pragma unroll
    for (int o = 1; o < 64; o <<= 1) v += __shfl_xor(v, o);
    return v;
}
__device__ __forceinline__ void transpose_item(const float* src, int ldsrc, int K, int k0, int c0, bf16_t* dst, int r0, const float* gain, LAS float* scr, int lane) {
    float v[32];
    const float* sp = src + (size_t)(k0 + (lane >> 5)) * ldsrc + c0 + (lane & 31);
#pragma unroll
    for (int i = 0; i < 32; ++i) v[i] = sp[(size_t)(2 * i) * ldsrc];
    if (gain) {
#pragma unroll
        for (int i = 0; i < 32; ++i) v[i] *= gain[k0 + 2 * i + (lane >> 5)];
    }
#pragma unroll
    for (int i = 0; i < 32; ++i) scr[(2 * i + (lane >> 5)) * 33 + (lane & 31)] = v[i];
    __builtin_amdgcn_wave_barrier();
    const int c = lane & 7;
#pragma unroll
    for (int j = 0; j < 4; ++j) { const int n = (lane >> 3) + 8 * j; const LAS float* sq = scr + (8 * c) * 33 + n;
        u32x4 o = {pk2(sq[0], sq[33]), pk2(sq[66], sq[99]), pk2(sq[132], sq[165]), pk2(sq[198], sq[231])};
        *(u32x4*)(dst + (size_t)(r0 + n) * K + k0 + 8 * c) = o; }
    __builtin_amdgcn_wave_barrier();
}
__device__ __forceinline__ void phase_prep(const Params& p, LAS unsigned char* lds) {
    const int tid = threadIdx.x, nb = gridDim.x, bid = blockIdx.x, wave = tid >> 6, lane = tid & 63;
    unsigned char* ws = p.ws;
    float* ss1 = (float*)(ws + WS_SS1); float* ss2 = (float*)(ws + WS_SS2); float* ss3 = (float*)(ws + WS_SS3);
    for (int i = bid * 512 + tid; i < T; i += nb * 512) { ss2[i] = 0.f; ss3[i] = 0.f; }
    if (bid == 0 && wave == 1) {
        float gq = fabsf(p.in[I_QNORM][lane]), gk = fabsf(p.in[I_KNORM][lane]);
#pragma unroll
        for (int o = 1; o < 64; o <<= 1) { gq = fmaxf(gq, __shfl_xor(gq, o)); gk = fmaxf(gk, __shfl_xor(gk, o)); }
        if (lane == 0) ((float*)(ws + WS_CTR))[32] = fminf(0.18033688f * 64.f * 1.02f * gq * gk, 60.f);
    }
    { bf16_t* wab = (bf16_t*)(ws + WS_WAB); const float* win = p.in[I_WIN]; const float* gn = p.in[I_MIXN];
      for (int idx = bid * 512 + tid; idx < 16 * 1024; idx += nb * 512) { const int n = idx >> 10, k = idx & 1023;
          wab[idx] = n < 8 ? f2bf(win[(size_t)k * 3592 + 2048 + n] * gn[k]) : (bf16_t)0; } }
    { const float* x = p.in[I_X]; bf16_t* xb = (bf16_t*)(ws + WS_X);
      for (int row = (bid * 8 + wave) * 2; row < T; row += nb * 16) {
          const f32x4* xr = (const f32x4*)(x + (size_t)row * 1024); f32x4 v[8]; float s0 = 0.f, s1 = 0.f;
#pragma unroll
          for (int j = 0; j < 8; ++j) v[j] = xr[lane + 64 * j];
#pragma unroll
          for (int j = 0; j < 4; ++j) { s0 += v[j][0] * v[j][0] + v[j][1] * v[j][1] + v[j][2] * v[j][2] + v[j][3] * v[j][3];
                                        s1 += v[4 + j][0] * v[4 + j][0] + v[4 + j][1] * v[4 + j][1] + v[4 + j][2] * v[4 + j][2] + v[4 + j][3] * v[4 + j][3]; }
          s0 = wave_sum(s0); s1 = wave_sum(s1); if (lane == 0) { ss1[row] = s0; ss1[row + 1] = s1; }
          const float rn0 = rsqrtf(s0 * (1.f / 1024.f) + EPS), rn1 = rsqrtf(s1 * (1.f / 1024.f) + EPS);
          u32x2* o = (u32x2*)(xb + (size_t)row * 1024);
#pragma unroll
          for (int j = 0; j < 8; ++j) { const float rn = j < 4 ? rn0 : rn1; u32x2 w = {pk2(v[j][0] * rn, v[j][1] * rn), pk2(v[j][2] * rn, v[j][3] * rn)}; o[lane + 64 * j] = w; }
      } }
    LAS float* scr = (LAS float*)(lds + wave * 8448);
    constexpr int N_GU = 88 * 16, N_D = 16 * 44, N_IN = 56 * 16, N_OUT = 16 * 16, N_ALL = 2 * (N_GU + N_D) + N_IN + N_OUT;
    for (int wi = bid * 8 + wave; wi < 2 * N_ALL; wi += nb * 8) {
        int r = wi >> 1; const int hf = (wi & 1) * 32;
        if (r < 2 * N_GU) { const int f = r / N_GU; r -= f * N_GU; const int rt = r >> 4, kt = r & 15, r0 = rt * 64;
            const int pn = r0 >> 8, bj = (r0 >> 7) & 1, rr = r0 & 127;
            const float* src = bj ? p.in[f ? I_F2U : I_F1U] : p.in[f ? I_F2G : I_F1G];
            transpose_item(src, FF, 1024, kt * 64, pn * 128 + rr + hf, (bf16_t*)(ws + (f ? WS_WGU2 : WS_WGU1)), r0 + hf, p.in[f ? I_F2N : I_F1N], scr, lane); continue; }
        r -= 2 * N_GU;
        if (r < 2 * N_D) { const int f = r / N_D; r -= f * N_D; const int rt = r / 44, kt = r % 44;
            transpose_item(p.in[f ? I_F2D : I_F1D], 1024, FF, kt * 64, rt * 64 + hf, (bf16_t*)(ws + (f ? WS_WD2 : WS_WD1)), rt * 64 + hf, nullptr, scr, lane); continue; }
        r -= 2 * N_D;
        if (r < N_IN) { const int rt = r >> 4, kt = r & 15, r0 = rt * 64;
            transpose_item(p.in[I_WIN], 3592, 1024, kt * 64, (r0 < 2048 ? r0 : r0 + 8) + hf, (bf16_t*)(ws + WS_WIN), r0 + hf, p.in[I_MIXN], scr, lane); continue; }
        r -= N_IN;
        { const int rt = r >> 4, kt = r & 15; transpose_item(p.in[I_WOUT], 1024, 1024, kt * 64, rt * 64 + hf, (bf16_t*)(ws + WS_WOUT), rt * 64 + hf, nullptr, scr, lane); }
    }
}

__device__ __forceinline__ void ab_rows(const Params& p) {
    const int tid = threadIdx.x, wave = tid >> 6, lane = tid & 63, fr = lane & 15, fq = lane >> 4;
    const bf16_t* x1b = (const bf16_t*)(p.ws + WS_X); const bf16_t* wab = (const bf16_t*)(p.ws + WS_WAB);
    const float* ss2 = (const float*)(p.ws + WS_SS2); float* ab = (float*)(p.ws + WS_AB);
    for (int wt = blockIdx.x * 8 + wave; wt < T / 16; wt += gridDim.x * 8) {
        const int row0 = wt * 16;
        const bf16_t* arow = x1b + (size_t)(row0 + fr) * 1024 + fq * 8; const bf16_t* brow = wab + (size_t)fr * 1024 + fq * 8;
        f32x4 acc = {0.f, 0.f, 0.f, 0.f};
#pragma unroll 8
        for (int ks = 0; ks < 32; ++ks) { const bf16x8 a = *(const bf16x8*)(arow + ks * 32), b = *(const bf16x8*)(brow + ks * 32); acc = MFMA16(a, b, acc); }
        if (fr < 8) {
#pragma unroll
            for (int j = 0; j < 4; ++j) { const int row = row0 + 4 * fq + j; ab[(size_t)row * 8 + fr] = acc[j] * rsqrtf(ss2[row] * (1.f / 1024.f) + EPS); }
        }
    }
}

constexpr int G1_HALF = 78080;
__device__ __forceinline__ void g1_item(const Params& p, LAS unsigned char* lds, int item) {
    int tid = threadIdx.x; asm volatile("" : "+v"(tid));
    const int hh = tid >> 8, tl = tid & 255, lane = tid & 63, wv4 = tl >> 6, fr = lane & 15, fq = lane >> 4;
    const int hp = item & 1, n = (item >> 1) & 63, b = item >> 7, h = 2 * hp + hh;
    const int chh = (b * 4 + h) * 64 + n, t0 = b * SEQ + n * 64;
    LAS unsigned char* base = lds + hh * G1_HALF;
    LAS bf16_t* Kb = (LAS bf16_t*)base; LAS bf16_t* Qb = (LAS bf16_t*)(base + 17408); LAS bf16_t* Vb = (LAS bf16_t*)(base + 34816);
    LAS float* Lm = (LAS float*)(base + 52224); LAS bf16_t* Ais = (LAS bf16_t*)(base + 68608);
    LAS float* gc = (LAS float*)(base + 76800); LAS float* beta = gc + 64; LAS float* eg = gc + 128;
    const bf16_t* Pa = (const bf16_t*)(p.ws + WS_R1);
    {
        const int dg = tl & 15, tg = tl >> 4, d0 = 8 * dg;
#pragma unroll
        for (int sec = 0; sec < 3; ++sec) {
            const int col = sec * 512 + h * 128 + d0;
            float w[4][8];
#pragma unroll
            for (int kk = 0; kk < 4; ++kk) { const f32x4 wa = *(const f32x4*)(p.in[I_CONV] + kk * 1536 + col), wb = *(const f32x4*)(p.in[I_CONV] + kk * 1536 + col + 4);
#pragma unroll
                for (int e = 0; e < 4; ++e) { w[kk][e] = wa[e]; w[kk][4 + e] = wb[e]; } }
            u32x4 xr[7];
#pragma unroll
            for (int rr = 0; rr < 7; ++rr) { const int tok = n * 64 + 4 * tg - 3 + rr;
                if (tok >= 0) xr[rr] = *(const u32x4*)(Pa + (size_t)(b * SEQ + tok) * PA_LD + col); else xr[rr] = (u32x4){0u, 0u, 0u, 0u}; }
            LAS bf16_t* dstb = sec == 0 ? Qb : (sec == 1 ? Kb : Vb);
#pragma unroll
            for (int ti = 0; ti < 4; ++ti) {
                float y[8]; float ssq = 0.f;
#pragma unroll
                for (int e = 0; e < 8; ++e) { float a = 0.f;
#pragma unroll
                    for (int kk = 0; kk < 4; ++kk) { const unsigned wd = xr[ti + kk][e >> 1]; a += w[kk][e] * ((e & 1) ? bfhi(wd) : bflo(wd)); }
                    y[e] = silu_f(a); ssq += y[e] * y[e]; }
                if (sec < 2) {
                    ssq += __shfl_xor(ssq, 1); ssq += __shfl_xor(ssq, 2); ssq += __shfl_xor(ssq, 4); ssq += __shfl_xor(ssq, 8);
                    const float rn = rsqrtf(ssq + EPS) * (sec == 0 ? 0.08838834764831845f : 1.f);
#pragma unroll
                    for (int e = 0; e < 8; ++e) y[e] *= rn;
                }
                u32x4 o = {pk2(y[0], y[1]), pk2(y[2], y[3]), pk2(y[4], y[5]), pk2(y[6], y[7])};
                *(LAS u32x4*)(dstb + (4 * tg + ti) * 136 + d0) = o;
            }
        }
    }
    if (tl < 64) {
        const int i = tl; const float* ab = (const float*)(p.ws + WS_AB);
        const float a = ab[(size_t)(t0 + i) * 8 + h], bb = ab[(size_t)(t0 + i) * 8 + 4 + h];
        const float A = expf(p.in[I_ALOG][h]); const float xx = a + p.in[I_DTB][h];
        const float sp = xx > 20.f ? xx : log1pf(expf(xx));
        float g = -A * sp;
#pragma unroll
        for (int off = 1; off < 64; off <<= 1) { const float t = __shfl_up(g, off); if (lane >= off) g += t; }
        const float bt = 1.f / (1.f + expf(-bb)), egi = expf(g);
        gc[i] = g; beta[i] = bt; eg[i] = egi; eg[64 + i] = bt * egi; eg[128 + i] = expf(__shfl(g, 63) - g);
        if (i == 63) ((float*)(p.ws + WS_GLAST))[chh] = expf(g);
    }
    __syncthreads();
    {
        const int mt = wv4;
#pragma unroll
        for (int nt = 0; nt < 4; ++nt) {
            f32x4 aK = {0.f, 0.f, 0.f, 0.f}, aQ = {0.f, 0.f, 0.f, 0.f};
#pragma unroll
            for (int ks = 0; ks < 4; ++ks) {
                const bf16x8 bk = *(const LAS bf16x8*)(Kb + (16 * nt + fr) * 136 + 32 * ks + 8 * fq);
                const bf16x8 ak = *(const LAS bf16x8*)(Kb + (16 * mt + fr) * 136 + 32 * ks + 8 * fq);
                const bf16x8 aq = *(const LAS bf16x8*)(Qb + (16 * mt + fr) * 136 + 32 * ks + 8 * fq);
                aK = MFMA16(ak, bk, aK); aQ = MFMA16(aq, bk, aQ);
            }
            const int j = 16 * nt + fr; const float gj = gc[j];
#pragma unroll
            for (int jj = 0; jj < 4; ++jj) { const int i = 16 * mt + 4 * fq + jj;
                const float dec = (i >= j) ? expf(gc[i] - gj) : 0.f;
                Lm[i * 64 + j] = (i > j) ? beta[i] * aK[jj] * dec : 0.f;
                Ais[i * 64 + 32 * (j >> 5) + pos32(j & 31)] = f2bf(aQ[jj] * dec); }
        }
    }
    {
        const int i = tl >> 2, g32 = tl & 3; const float sc = eg[i];
        float a[32];
#pragma unroll
        for (int c4 = 0; c4 < 4; ++c4) { const u32x4 v = *(const LAS u32x4*)(Qb + i * 136 + 32 * g32 + 8 * c4);
#pragma unroll
            for (int e = 0; e < 4; ++e) { a[8 * c4 + 2 * e] = bflo(v[e]) * sc; a[8 * c4 + 2 * e + 1] = bfhi(v[e]) * sc; } }
        bf16_t* dq = (bf16_t*)(p.ws + WS_QD) + (size_t)chh * 8192 + i * 128 + 32 * g32;
#pragma unroll
        for (int c4 = 0; c4 < 4; ++c4) { u32x4 o;
#pragma unroll
            for (int e = 0; e < 4; ++e) o[e] = pk2(a[act32(8 * c4 + 2 * e)], a[act32(8 * c4 + 2 * e + 1)]);
            *(u32x4*)(dq + 8 * c4) = o; }
    }
    {
        const int d = tl >> 1, tgp = tl & 1; const float gl = gc[63];
        bf16_t* dk = (bf16_t*)(p.ws + WS_KD) + (size_t)chh * 8192 + d * 64 + 32 * tgp;
#pragma unroll
        for (int c4 = 0; c4 < 4; ++c4) { u32x4 o;
#pragma unroll
            for (int e = 0; e < 4; ++e) { const int i0 = 32 * tgp + act32(8 * c4 + 2 * e), i1 = 32 * tgp + act32(8 * c4 + 2 * e + 1);
                o[e] = pk2(bf2f(Kb[i0 * 136 + d]) * expf(gl - gc[i0]), bf2f(Kb[i1 * 136 + d]) * expf(gl - gc[i1])); }
            *(u32x4*)(dk + 8 * c4) = o; }
    }
    __syncthreads();
#pragma unroll
    for (int ii = 0; ii < 2; ++ii) { const int id = tl + 256 * ii; *(u32x4*)((bf16_t*)(p.ws + WS_AI) + (size_t)chh * 4096 + id * 8) = *(const LAS u32x4*)(Ais + id * 8); }
    {
        const int c = tl; f32x2 xp[32];
        const LAS bf16_t* rsrc = c < 128 ? Vb + c : Kb + (c - 128);
        const LAS float* rsc = c < 128 ? beta : eg + 64;
#pragma unroll
        for (int q = 0; q < 32; ++q) xp[q] = (f32x2){0.f, 0.f};
#pragma unroll
        for (int i = 0; i < 64; ++i) {
            f32x2 acc = {rsc[i] * bf2f(rsrc[i * 136]), 0.f};
#pragma unroll
            for (int j4 = 0; j4 < (i + 3) / 4; ++j4) { const f32x4 l = *(const LAS f32x4*)(Lm + i * 64 + 4 * j4);
                acc -= (f32x2){l[0], l[1]} * xp[2 * j4]; if (4 * j4 + 2 < i) acc -= (f32x2){l[2], l[3]} * xp[2 * j4 + 1]; }
            const float xi = acc[0] + acc[1];
            if (i & 1) xp[i >> 1][1] = xi; else xp[i >> 1][0] = xi;
            if ((i & 3) == 3) __builtin_amdgcn_sched_barrier(0);
        }
#define x(i_) xp[(i_) >> 1][(i_) & 1]
        __syncthreads();
        LAS bf16_t* stg = (LAS bf16_t*)base;
        if (c < 128) {
            LAS bf16_t* us = stg + 8192 + (c >> 4) * 1024 + (c & 15) * 4;
#pragma unroll
            for (int mt = 0; mt < 4; ++mt)
#pragma unroll
                for (int q = 0; q < 4; ++q) { const int i = 16 * mt + 4 * q; u32x2 o = {pk2(x(i), x(i + 1)), pk2(x(i + 2), x(i + 3))}; *(LAS u32x2*)(us + mt * 256 + q * 64) = o; }
        } else {
            const int kd = c - 128; LAS bf16_t* wn = stg + 32 * (kd >> 5) + pos32(kd & 31);
#pragma unroll
            for (int i = 0; i < 64; ++i) wn[i * 128] = f2bf(-x(i));
        }
    }
#undef x
    __syncthreads();
    {
        LAS bf16_t* stg = (LAS bf16_t*)base;
        bf16_t* gw = (bf16_t*)(p.ws + WS_WN) + (size_t)chh * 8192; bf16_t* gu = (bf16_t*)(p.ws + WS_US) + (size_t)chh * 8192;
#pragma unroll
        for (int ii = 0; ii < 4; ++ii) { const int id = tl + 256 * ii;
            *(u32x4*)(gw + id * 8) = *(const LAS u32x4*)(stg + id * 8);
            *(u32x4*)(gu + id * 8) = *(const LAS u32x4*)(stg + 8192 + id * 8); }
    }
    __syncthreads();
}

__device__ __forceinline__ void moba_prep_item(const Params& p, LAS unsigned char* lds, int item, bool dry = false) {
    const int tid = threadIdx.x;
    const int h = item & 7, blk = (item >> 3) & 15, b = item >> 7, t0 = b * SEQ + blk * 256;
    LAS float* scr = (LAS float*)lds; LAS bf16_t* vt = (LAS bf16_t*)(lds + 66560); LAS float* part = (LAS float*)(lds + 100352);
    const bf16_t* Pa = (const bf16_t*)(p.ws + WS_R1); bf16_t* O = (bf16_t*)(p.ws + WS_O);
    bf16_t* kn = (bf16_t*)p.out; bf16_t* Vt = (bf16_t*)p.out + (size_t)T * 512;
    {
        const int key = tid >> 1, half = tid & 1;
        const bf16_t* src = O + (size_t)(t0 + key) * 1024 + 512 + h * 64 + half * 32;
        const int kp = 32 * (key >> 5) + pos32(key & 31);
#pragma unroll
        for (int c4 = 0; c4 < 4; ++c4) { const u32x4 v = *(const u32x4*)(src + 8 * c4);
#pragma unroll
            for (int e = 0; e < 4; ++e) { vt[(half * 32 + 8 * c4 + 2 * e) * 264 + kp] = (bf16_t)(v[e] & 0xffffu); vt[(half * 32 + 8 * c4 + 2 * e + 1) * 264 + kp] = (bf16_t)(v[e] >> 16); } }
    }
    __syncthreads();
    {
        const int role = tid >> 8, tok = tid & 255;
        const bf16_t* src = role == 0 ? Pa + (size_t)(t0 + tok) * PA_LD + 2048 + h * 64 : O + (size_t)(t0 + tok) * 1024 + h * 64;
        const float* gain = p.in[role == 0 ? I_QNORM : I_KNORM];
        float v[64]; float ssq = 0.f;
#pragma unroll
        for (int c8 = 0; c8 < 8; ++c8) { const u32x4 w = *(const u32x4*)(src + 8 * c8);
#pragma unroll
            for (int e = 0; e < 4; ++e) { v[8 * c8 + 2 * e] = bflo(w[e]); v[8 * c8 + 2 * e + 1] = bfhi(w[e]); } }
#pragma unroll
        for (int i = 0; i < 64; ++i) ssq += v[i] * v[i];
        const float rn = rsqrtf(ssq * (1.f / 64.f) + EPS);
#pragma unroll
        for (int i = 0; i < 64; ++i) v[i] = v[i] * rn * gain[i];
        const float posf = (float)(blk * 256 + tok);
        const float invf[8] = {1.0f, 0.1939227432012558f, 0.03760603070259094f, 0.007292664609849453f, 0.0014142135623842478f, 0.00027424818836152554f, 5.318296098266728e-05f, 1.0313386155758053e-05f};
#pragma unroll
        for (int i = 0; i < 8; ++i) {
            const float ang = posf * invf[i];
            double rev = (double)ang * 0.15915494309189535; rev -= rint(rev);
            const float sn = __builtin_amdgcn_sinf((float)rev), cs = __builtin_amdgcn_cosf((float)rev);
            const float x1 = v[i], x2 = v[i + 8];
            v[i] = x1 * cs - x2 * sn; v[i + 8] = x2 * cs + x1 * sn;
        }
        bf16_t* dst = role == 0 ? (dry ? (bf16_t*)(p.ws + WS_END) + (size_t)tok * 1024 : O + (size_t)(t0 + tok) * 1024) + 512 + h * 64 : kn + (size_t)(t0 + tok) * 512 + h * 64;
#pragma unroll
        for (int c8 = 0; c8 < 8; ++c8) { u32x4 w = {pk2(v[8 * c8], v[8 * c8 + 1]), pk2(v[8 * c8 + 2], v[8 * c8 + 3]), pk2(v[8 * c8 + 4], v[8 * c8 + 5]), pk2(v[8 * c8 + 6], v[8 * c8 + 7])};
            *(u32x4*)(dst + 8 * c8) = w; }
        if (role == 1) {
#pragma unroll
            for (int i = 0; i < 64; ++i) scr[tok * 65 + i] = v[i];
        }
    }
    __syncthreads();
    if (tid < 256) { const int d = tid & 63, pt = tid >> 6; float s = 0.f;
        for (int r = 0; r < 64; ++r) s += scr[(64 * pt + r) * 65 + d];
        part[pt * 64 + d] = s; }
#pragma unroll
    for (int ii = 0; ii < 4; ++ii) { const int id = tid + 512 * ii, d = id >> 5, cc = id & 31;
        *(u32x4*)(Vt + ((size_t)((b * 8 + h) * 16 + blk) * 64 + d) * 256 + cc * 8) = *(const LAS u32x4*)(vt + d * 264 + cc * 8); }
    __syncthreads();
    if (tid < 64) ((float*)(p.ws + WS_KMEAN))[((size_t)((b * 8 + h) * 16) + blk) * 64 + tid] = (part[tid] + part[64 + tid] + part[128 + tid] + part[192 + tid]) * (1.f / 256.f);
    __syncthreads();
}

__device__ __forceinline__ float row16_sum(float v) {
    v += __builtin_bit_cast(float, __builtin_amdgcn_update_dpp(0, __builtin_bit_cast(int, v), 0xB1, 0xF, 0xF, true));
    v += __builtin_bit_cast(float, __builtin_amdgcn_update_dpp(0, __builtin_bit_cast(int, v), 0x4E, 0xF, 0xF, true));
    v += __builtin_bit_cast(float, __builtin_amdgcn_update_dpp(0, __builtin_bit_cast(int, v), 0x141, 0xF, 0xF, true));
    v += __builtin_bit_cast(float, __builtin_amdgcn_update_dpp(0, __builtin_bit_cast(int, v), 0x140, 0xF, 0xF, true));
    return v;
}
template <int DRY>
__device__ __forceinline__ void gdn_scan(const Params& p, LAS unsigned char* lds, int bh) {
    const int tid = threadIdx.x, wv = __builtin_amdgcn_readfirstlane(tid >> 6), lane = tid & 63, fr = lane & 15, fq = lane >> 4;
    const int b = bh >> 2, h = bh & 3;
    const bool cw = wv < 4; const int w4 = wv & 3, tid2 = tid & 255;
    constexpr int W_OFF = 0, Q_OFF = 16384, K_OFF = 32768, A_OFF = 49152, BUF = 57344, OT_OFF = 2 * BUF, RED_OFF = OT_OFF + 2 * 16384;
    LAS float* red = (LAS float*)(lds + RED_OFF);
    const bf16_t* Wn = (const bf16_t*)(p.ws + WS_WN); const bf16_t* Qd = (const bf16_t*)(p.ws + WS_QD); const bf16_t* Kd = (const bf16_t*)(p.ws + WS_KD);
    const bf16_t* Ai = (const bf16_t*)(p.ws + WS_AI); const bf16_t* Us = (const bf16_t*)(p.ws + WS_US); const float* glast = (const float*)(p.ws + WS_GLAST);
    const bf16_t* Pa = (const bf16_t*)(p.ws + WS_R1); bf16_t* O = (bf16_t*)(p.ws + WS_O);
    f32x4 S[8][2];
#pragma unroll
    for (int i = 0; i < 8; ++i) { S[i][0] = (f32x4){0.f, 0.f, 0.f, 0.f}; S[i][1] = (f32x4){0.f, 0.f, 0.f, 0.f}; }
    const int fcc = tid2 & 15;
    LAS float* gainl = (LAS float*)(lds + RED_OFF + 2048);
    if (tid < 128) gainl[tid] = p.in[I_ONORM][tid];
    u32x2 ru[8]; float gl_next = 0.f;
#pragma unroll
    for (int k = 0; k < 8; ++k) ru[k] = (u32x2){0u, 0u};
    const bf16_t* rub = cw ? Us + ((size_t)bh * 64 * 8 + 2 * w4) * 1024 + lane * 4 : Pa + ((size_t)b * SEQ + (tid2 >> 4)) * PA_LD + 1536 + h * 128 + 8 * fcc;
    const size_t ru_step = cw ? (size_t)8192 : (size_t)64 * PA_LD;
    const int ru_a = cw ? 256 : 16 * PA_LD, ru_b = cw ? 1024 : 4;
#define SCAN_GLOAD(nn, zn, par) do { const size_t chh = (size_t)bh * 64 + ((DRY & 4) ? 0 : (nn)); LAS unsigned char* db = lds + ((par) & 1) * BUF + wv * 1024; \
        int lq = lane; asm volatile("" : "+v"(lq));            \
        _Pragma("unroll") for (int i = 0; i < 2; ++i) { \
            const int r16 = 4 * (wv + 8 * i) + (lq >> 4), c16 = (lq & 15) ^ (r16 & 15); const unsigned gw = (unsigned)(r16 * 128 + c16 * 8); \
            const int r8 = 8 * (wv + 8 * i) + (lq >> 3), c8 = (lq & 7) ^ ((r8 >> 1) & 7); const unsigned gk = (unsigned)(r8 * 64 + c8 * 8); \
            __builtin_amdgcn_global_load_lds((const unsigned*)(Wn + chh * 8192 + gw), (LAS unsigned*)(db + W_OFF + i * 8192), 16, 0, 0); \
            __builtin_amdgcn_global_load_lds((const unsigned*)(Qd + chh * 8192 + gw), (LAS unsigned*)(db + Q_OFF + i * 8192), 16, 0, 0); \
            __builtin_amdgcn_global_load_lds((const unsigned*)(Kd + chh * 8192 + gk), (LAS unsigned*)(db + K_OFF + i * 8192), 16, 0, 0); } \
        { const int r8 = 8 * wv + (lq >> 3), c8 = (lq & 7) ^ ((r8 >> 1) & 7); \
          __builtin_amdgcn_global_load_lds((const unsigned*)(Ai + chh * 4096 + (unsigned)(r8 * 64 + c8 * 8)), (LAS unsigned*)(db + A_OFF), 16, 0, 0); } \
        { const bf16_t* rp = rub + (size_t)(cw ? ((DRY & 4) ? 0 : (nn)) : (zn)) * ru_step; \
          _Pragma("unroll") for (int k = 0; k < 8; ++k) ru[k] = *(const u32x2*)(rp + (k >> 1) * ru_a + (k & 1) * ru_b); } \
        if (cw) gl_next = glast[chh]; } while (0)
#define SCAN_STAGE(nn) do { \
        if (cw) { _Pragma("unroll") for (int mt = 0; mt < 4; ++mt) _Pragma("unroll") for (int ct = 0; ct < 2; ++ct) vn[mt][ct] = (f32x4){bflo(ru[2 * mt + ct][0]), bfhi(ru[2 * mt + ct][0]), bflo(ru[2 * mt + ct][1]), bfhi(ru[2 * mt + ct][1])}; gl = gl_next; } } while (0)
#define SCAN_FINAL(nn) do { const int tq = b * SEQ + (nn) * 64; const LAS float* rd = red + ((nn) & 1) * 256; const LAS unsigned char* ot = lds + OT_OFF + ((nn) & 1) * 16384; \
        _Pragma("unroll") for (int ii = 0; ii < 4; ++ii) { const int row = (tid2 >> 4) + 16 * ii; \
            const float tot = (rd[row] + rd[64 + row]) + (rd[128 + row] + rd[192 + row]); const float rstd = rsqrtf(tot * (1.f / 128.f) + EPS); \
            const u32x4 ov = *(const LAS u32x4*)(ot + row * 256 + ((fcc ^ (2 * ((row >> 2) & 3))) * 16)); const u32x4 zz = {ru[2 * ii][0], ru[2 * ii][1], ru[2 * ii + 1][0], ru[2 * ii + 1][1]}; u32x4 res; \
            const f32x4 g0 = *(const LAS f32x4*)(gainl + 8 * fcc), g1 = *(const LAS f32x4*)(gainl + 8 * fcc + 4); const float fgain[8] = {g0[0], g0[1], g0[2], g0[3], g1[0], g1[1], g1[2], g1[3]}; \
            _Pragma("unroll") for (int e = 0; e < 4; ++e) res[e] = pk2(bflo(ov[e]) * rstd * fgain[2 * e] * silu_f(bflo(zz[e])), bfhi(ov[e]) * rstd * fgain[2 * e + 1] * silu_f(bfhi(zz[e]))); \
            if ((DRY & 1) == 0) *(u32x4*)(O + (size_t)(tq + row) * 1024 + h * 128 + 8 * fcc) = res; else if (res[0] == 0x12345u) O[0] = 1; } } while (0)
    SCAN_GLOAD(0, 0, 0);
    f32x4 vn[4][2]; float gl = 0.f;
    SCAN_STAGE(0);
    for (int n = 0; n < 64; ++n) {
        LAS unsigned char* buf = lds + (n & 1) * BUF;
        asm volatile("s_waitcnt vmcnt(0)" ::: "memory");
        asm volatile("s_waitcnt lgkmcnt(0)" ::: "memory");
        __builtin_amdgcn_s_barrier();
        asm volatile("" ::: "memory");
        if (!cw) SCAN_FINAL(n > 0 ? n - 1 : 0);
        SCAN_GLOAD(n + 1 < 64 ? n + 1 : 63, n, n + 1);
        __builtin_amdgcn_sched_barrier(0);
        if (cw) {
            bf16x8 Sb[4][2];
#pragma unroll
            for (int ks = 0; ks < 4; ++ks) { Sb[ks][0] = pack8(S[2 * ks][0], S[2 * ks + 1][0]); Sb[ks][1] = pack8(S[2 * ks][1], S[2 * ks + 1][1]); }
#pragma unroll
            for (int mt = 0; mt < 4; ++mt)
#pragma unroll
                for (int ks = 0; ks < 4; ++ks) { const bf16x8 a = *(const LAS bf16x8*)(buf + W_OFF + (16 * mt + fr) * 256 + (((4 * ks + fq) ^ fr) * 16));
                    vn[mt][0] = MFMA16(a, Sb[ks][0], vn[mt][0]); vn[mt][1] = MFMA16(a, Sb[ks][1], vn[mt][1]); }
            __builtin_amdgcn_sched_barrier(0);
            bf16x8 vb[2][2];
#pragma unroll
            for (int ct = 0; ct < 2; ++ct) { vb[0][ct] = pack8(vn[0][ct], vn[1][ct]); vb[1][ct] = pack8(vn[2][ct], vn[3][ct]); }
#pragma unroll
            for (int mt = 0; mt < 4; ++mt) { vn[mt][0] = (f32x4){0.f, 0.f, 0.f, 0.f}; vn[mt][1] = (f32x4){0.f, 0.f, 0.f, 0.f};
#pragma unroll
                for (int ks = 0; ks < 4; ++ks) { const bf16x8 a = *(const LAS bf16x8*)(buf + Q_OFF + (16 * mt + fr) * 256 + (((4 * ks + fq) ^ fr) * 16));
                    vn[mt][0] = MFMA16(a, Sb[ks][0], vn[mt][0]); vn[mt][1] = MFMA16(a, Sb[ks][1], vn[mt][1]); }
#pragma unroll
                for (int ks = 0; ks < 2; ++ks) { const bf16x8 a = *(const LAS bf16x8*)(buf + A_OFF + (16 * mt + fr) * 128 + (((4 * ks + fq) ^ (fr >> 1)) * 16));
                    vn[mt][0] = MFMA16(a, vb[ks][0], vn[mt][0]); vn[mt][1] = MFMA16(a, vb[ks][1], vn[mt][1]); } }
            __builtin_amdgcn_sched_barrier(0);
            LAS bf16_t* ot = (LAS bf16_t*)(lds + OT_OFF + (n & 1) * 16384);
#pragma unroll
            for (int mt = 0; mt < 4; ++mt) {
                f32x4 sq = vn[mt][0] * vn[mt][0] + vn[mt][1] * vn[mt][1];
#pragma unroll
                for (int j = 0; j < 4; ++j) { sq[j] = row16_sum(sq[j]);
                    const int row = 16 * mt + 4 * fq + j;
                    ot[row * 128 + ((32 * w4 + fr) ^ (16 * fq))] = f2bf(vn[mt][0][j]);
                    ot[row * 128 + ((32 * w4 + 16 + fr) ^ (16 * fq))] = f2bf(vn[mt][1][j]); }
                if (fr == 0) *(LAS f32x4*)(red + (n & 1) * 256 + w4 * 64 + 16 * mt + 4 * fq) = sq;
            }
                    __builtin_amdgcn_sched_barrier(0);
#pragma unroll
            for (int m8 = 0; m8 < 8; ++m8) { S[m8][0] = S[m8][0] * gl; S[m8][1] = S[m8][1] * gl;
#pragma unroll
                for (int ks = 0; ks < 2; ++ks) { const bf16x8 a = *(const LAS bf16x8*)(buf + K_OFF + (16 * m8 + fr) * 128 + (((4 * ks + fq) ^ (fr >> 1)) * 16));
                    S[m8][0] = MFMA16(a, vb[ks][0], S[m8][0]); S[m8][1] = MFMA16(a, vb[ks][1], S[m8][1]); } }
        }
        SCAN_STAGE(n + 1);
    }
    asm volatile("s_waitcnt vmcnt(0)" ::: "memory");
    __syncthreads();
    if (!cw) SCAN_FINAL(63);
#undef SCAN_FINAL
#undef SCAN_STAGE
#undef SCAN_GLOAD
    __syncthreads();
}

__device__ __forceinline__ void moba_attn_item(const Params& p, LAS unsigned char* lds, int item, bool dry = false) {
    const int tid = threadIdx.x, wv = tid >> 6, lane = tid & 63, fr = lane & 15, fq = lane >> 4;
    const int blk = 15 - (item >> 6), bh = item & 63, b = bh >> 3, h = bh & 7, t0 = b * SEQ + blk * 256;
    constexpr int KT_B = 16384, BUF = 32768;
    LAS float* kml = (LAS float*)(lds + 98304); LAS float* gts = (LAS float*)(lds + 102144); LAS unsigned* sel = (LAS unsigned*)(lds + 118528);
    bf16_t* O = (bf16_t*)(p.ws + WS_O); const bf16_t* kn = (const bf16_t*)p.out; const bf16_t* Vt = (const bf16_t*)p.out + (size_t)T * 512;
    const float* kmean = (const float*)(p.ws + WS_KMEAN) + (size_t)((b * 8 + h) * 16) * 64;
    unsigned kofs[2], vofs[2];
#pragma unroll
    for (int i = 0; i < 2; ++i) { const int pc = wv + 8 * i; const int rk = 8 * pc + (lane >> 3), ck = (lane & 7) ^ ((rk >> 1) & 7); kofs[i] = (unsigned)(rk * 512 + ck * 8);
        const int rv = 4 * pc + (lane >> 4), cv = (lane & 15) ^ (rv & 15); vofs[i] = (unsigned)(rv * 256 + cv * 8); }
    const bf16_t* knh = kn + (size_t)b * SEQ * 512 + h * 64; const bf16_t* vth = Vt + (size_t)((b * 8 + h) * 16) * 16384;
#define ATT_DMA(tix_, par_) do { const int nb_ = (tix_) >> 1, hf_ = (tix_) & 1; LAS unsigned char* db = lds + (par_) * BUF + wv * 1024; \
        _Pragma("unroll") for (int i = 0; i < 2; ++i) { \
            __builtin_amdgcn_global_load_lds((const unsigned*)(knh + (size_t)(nb_ * 256 + hf_ * 128) * 512 + kofs[i]), (LAS unsigned*)(db + i * 8192), 16, 0, 0); \
            __builtin_amdgcn_global_load_lds((const unsigned*)(vth + (size_t)nb_ * 16384 + hf_ * 128 + vofs[i]), (LAS unsigned*)(db + KT_B + i * 8192), 16, 0, 0); } } while (0)
    const int ntiles = 2 * blk + 2;
    ATT_DMA(0, 0); ATT_DMA(1, 1);
    bf16x8 qf[2][2];
#pragma unroll
    for (int nt = 0; nt < 2; ++nt)
#pragma unroll
        for (int ks = 0; ks < 2; ++ks) qf[nt][ks] = *(const bf16x8*)(O + (size_t)(t0 + 32 * wv + 16 * nt + fr) * 1024 + 512 + h * 64 + 32 * ks + 8 * fq);
    if (blk > 3) {
        for (int idx = tid; idx < blk * 64; idx += 512) kml[idx] = kmean[idx];
        __syncthreads();
        {
            const int qi = tid & 255, part = tid >> 8; const bf16_t* src = O + (size_t)(t0 + qi) * 1024 + 512 + h * 64;
            u32x4 qp[8];
#pragma unroll
            for (int c8 = 0; c8 < 8; ++c8) qp[c8] = *(const u32x4*)(src + 8 * c8);
            for (int nb = part; nb < blk; nb += 2) { float s = 0.f;
#pragma unroll
                for (int c8 = 0; c8 < 8; ++c8) { const f32x4 ka = *(const LAS f32x4*)(kml + nb * 64 + 8 * c8), kb = *(const LAS f32x4*)(kml + nb * 64 + 8 * c8 + 4);
                    s += bflo(qp[c8][0]) * ka[0] + bfhi(qp[c8][0]) * ka[1] + bflo(qp[c8][1]) * ka[2] + bfhi(qp[c8][1]) * ka[3]
                       + bflo(qp[c8][2]) * kb[0] + bfhi(qp[c8][2]) * kb[1] + bflo(qp[c8][3]) * kb[2] + bfhi(qp[c8][3]) * kb[3]; }
                gts[qi * 16 + nb] = s; }
        }
        __syncthreads();
        if (tid < 256) {
            float v1 = -INFINITY, v2 = -INFINITY, v3 = -INFINITY; int i1 = 0, i2 = 0, i3 = 0;
            for (int nb = 0; nb < blk; ++nb) { const float g = gts[tid * 16 + nb];
                if (g > v1) { v3 = v2; i3 = i2; v2 = v1; i2 = i1; v1 = g; i1 = nb; }
                else if (g > v2) { v3 = v2; i3 = i2; v2 = g; i2 = nb; }
                else if (g > v3) { v3 = g; i3 = nb; } }
            sel[tid] = (1u << i1) | (1u << i2) | (1u << i3);
        }
    } else { if (tid < 256) sel[tid] = (1u << blk) - 1u; }
    __syncthreads();
    unsigned selm[2]; selm[0] = sel[32 * wv + fr]; selm[1] = sel[32 * wv + 16 + fr];
    float lrun[2] = {0.f, 0.f};
    const float mref = ((const float*)(p.ws + WS_CTR))[32];
    f32x4 oacc[4][2];
#pragma unroll
    for (int dt = 0; dt < 4; ++dt) { oacc[dt][0] = (f32x4){0.f, 0.f, 0.f, 0.f}; oacc[dt][1] = (f32x4){0.f, 0.f, 0.f, 0.f}; }
    int bcur = 0;
    for (int tix = 0; tix < ntiles; ++tix) {
        LAS unsigned char* buf = lds + bcur * BUF;
        asm volatile("s_waitcnt vmcnt(4)" ::: "memory");
        __builtin_amdgcn_s_barrier();
        asm volatile("" ::: "memory");
        { const int nx = tix + 2 < ntiles ? tix + 2 : ntiles - 1; const int bn = bcur == 0 ? 2 : bcur - 1;
          ATT_DMA(nx, bn); }
        const int nb = tix >> 1, half = tix & 1; const bool own = (nb == blk);
        bool active;
        if (own) active = (128 * half <= 32 * wv + 31);
        else active = __any((int)(((selm[0] | selm[1]) >> nb) & 1u)) != 0;
        if (active) {
            f32x4 s[8][2];
#pragma unroll
            for (int kt = 0; kt < 8; ++kt) {
                const bf16x8 k0 = *(const LAS bf16x8*)(buf + (16 * kt + fr) * 128 + ((fq ^ (fr >> 1)) * 16));
                const bf16x8 k1 = *(const LAS bf16x8*)(buf + (16 * kt + fr) * 128 + (((4 + fq) ^ (fr >> 1)) * 16));
#pragma unroll
                for (int nt = 0; nt < 2; ++nt) { f32x4 a = {0.f, 0.f, 0.f, 0.f}; a = MFMA16(k0, qf[nt][0], a); a = MFMA16(k1, qf[nt][1], a); s[kt][nt] = a; }
            }
            constexpr float SC = 0.18033688011112042f;
            if (own) {
                asm volatile("" ::: "memory");
#pragma unroll
                for (int nt = 0; nt < 2; ++nt) { const int qloc = 32 * wv + 16 * nt + fr - 128 * half - 4 * fq;
#pragma unroll
                    for (int kt = 0; kt < 8; ++kt)
#pragma unroll
                        for (int j = 0; j < 4; ++j) s[kt][nt][j] = (16 * kt + j <= qloc) ? s[kt][nt][j] : -INFINITY; }
            }
#pragma unroll
            for (int nt = 0; nt < 2; ++nt) {
                const bool colsel = own || (((selm[nt] >> nb) & 1u) != 0u);
                const float mneg = colsel ? -mref : -INFINITY;
                float ls = 0.f;
#pragma unroll
                for (int kt = 0; kt < 8; ++kt)
#pragma unroll
                    for (int j = 0; j < 4; ++j) { const float pv = __builtin_amdgcn_exp2f(__builtin_fmaf(s[kt][nt][j], SC, mneg)); s[kt][nt][j] = pv; ls += pv; }
                lrun[nt] += ls;
            }
#pragma unroll
            for (int ks = 0; ks < 4; ++ks) {
                const bf16x8 pb0 = pack8(s[2 * ks][0], s[2 * ks + 1][0]), pb1 = pack8(s[2 * ks][1], s[2 * ks + 1][1]);
#pragma unroll
                for (int dt = 0; dt < 4; ++dt) { const bf16x8 vf = *(const LAS bf16x8*)(buf + KT_B + (16 * dt + fr) * 256 + (((4 * ks + fq) ^ fr) * 16));
                    oacc[dt][0] = MFMA16(vf, pb0, oacc[dt][0]); oacc[dt][1] = MFMA16(vf, pb1, oacc[dt][1]); }
            }
        }
        bcur = bcur == 2 ? 0 : bcur + 1;
    }
#undef ATT_DMA
    asm volatile("s_waitcnt vmcnt(0)" ::: "memory");
#pragma unroll
    for (int nt = 0; nt < 2; ++nt) {
        float lt = lrun[nt]; lt += __shfl_xor(lt, 16); lt += __shfl_xor(lt, 32); const float inv = 1.f / lt;
        bf16_t* dst = (dry ? (bf16_t*)(p.ws + WS_END) + (size_t)(32 * wv + 16 * nt + fr) * 1024 : O + (size_t)(t0 + 32 * wv + 16 * nt + fr) * 1024) + 512 + h * 64 + 4 * fq;
#pragma unroll
        for (int dt = 0; dt < 4; ++dt) { u32x2 w = {pk2(oacc[dt][nt][0] * inv, oacc[dt][nt][1] * inv), pk2(oacc[dt][nt][2] * inv, oacc[dt][nt][3] * inv)}; *(u32x2*)(dst + 16 * dt) = w; }
    }
    __syncthreads();
}

__device__ __forceinline__ void grid_barrier(unsigned* ctl, unsigned gen) {
    __syncthreads();
    if (threadIdx.x == 0) {
        __builtin_amdgcn_fence(__ATOMIC_RELEASE, "agent");
        const unsigned G = gridDim.x;
        if ((G & 7u) == 0u) {
            const unsigned gs = G >> 3, g = blockIdx.x & 7u;
            const unsigned old = __hip_atomic_fetch_add(ctl + 128 + 32 * g, 1u, __ATOMIC_RELAXED, __HIP_MEMORY_SCOPE_AGENT);
            if (old + 1u == gs * gen) {
                __builtin_amdgcn_fence(__ATOMIC_ACQ_REL, "agent");
                __hip_atomic_fetch_add(ctl + 64, 1u, __ATOMIC_RELAXED, __HIP_MEMORY_SCOPE_AGENT);
            }
            while (__hip_atomic_load(ctl + 64, __ATOMIC_RELAXED, __HIP_MEMORY_SCOPE_AGENT) < 8u * gen) __builtin_amdgcn_s_sleep(1);
        } else {
            __hip_atomic_fetch_add(ctl + 16, 1u, __ATOMIC_RELAXED, __HIP_MEMORY_SCOPE_AGENT);
            while (__hip_atomic_load(ctl + 16, __ATOMIC_RELAXED, __HIP_MEMORY_SCOPE_AGENT) < G * gen) __builtin_amdgcn_s_sleep(2);
        }
        __builtin_amdgcn_fence(__ATOMIC_ACQUIRE, "agent");
    }
    __syncthreads();
}
__device__ __forceinline__ void fill_row_scales(const pg8::StaticOrder& S, const float* ss, LAS float* rt) {
    const int tid = threadIdx.x;
    if (tid < 256) {
        float t[12];
#pragma unroll
        for (int i = 0; i < 12; ++i) { pg8::Unit u; t[i] = S.next(i, u) ? ss[u.pm * 256 + tid] : 1024.f; }
#pragma unroll
        for (int i = 0; i < 12; ++i) rt[i * 256 + tid] = rsqrtf(t[i] * (1.f / 1024.f) + EPS);
    }
    __syncthreads();
}
template <int PH>
__device__ __forceinline__ void run_phase(const Params& p, LAS unsigned char* lds) {
    unsigned char* ws = p.ws;
    if constexpr (PH == 0) { if constexpr (PH_MASK & 1) { phase_prep(p, lds); if constexpr (REP & 1) { __syncthreads(); phase_prep(p, lds); } } }
    else if constexpr (PH == 1 || PH == 7) {
        if constexpr (PH_MASK & 2) {
        pg8::Gemm g{(const bf16_t*)(ws + WS_X), (const bf16_t*)(ws + (PH == 1 ? WS_WGU1 : WS_WGU2)), T, 5632, 1024};
        pg8::StaticOrder S; S.init(g.M, g.N, (int)gridDim.x, (int)blockIdx.x);
        EpiSwiGLU<(PH == 7)> E{(bf16_t*)(ws + WS_R1), (const LAS float*)(lds + RT_OFF)};
        if constexpr (PH == 7) fill_row_scales(S, (const float*)(ws + WS_SS3), (LAS float*)(lds + RT_OFF));
        pg8::gemm_phase(lds, g, S, E);
        if constexpr ((REP & 2) && PH == 1) pg8::gemm_phase(lds, g, S, E); }
    } else if constexpr (PH == 2 || PH == 6 || PH == 8) {
        if constexpr (PH_MASK & 4) {
        bf16_t* xb = (bf16_t*)(ws + WS_X);
        if constexpr (PH == 2) { pg8::Gemm g{(const bf16_t*)(ws + WS_R1), (const bf16_t*)(ws + WS_WD1), T, 1024, FF}; EpiResid<0> E{p.in[I_X], nullptr, nullptr, xb, (float*)(ws + WS_SS2), 0.5f};
            pg8::StaticOrder S; S.init(g.M, g.N, (int)gridDim.x, (int)blockIdx.x); pg8::gemm_phase(lds, g, S, E);
            if constexpr (REP & 4) { E.ss = nullptr; pg8::gemm_phase(lds, g, S, E); } }
        else if constexpr (PH == 6) { pg8::Gemm g{(const bf16_t*)(ws + WS_O), (const bf16_t*)(ws + WS_WOUT), T, 1024, 1024}; EpiResid<1> E{nullptr, xb, nullptr, xb, (float*)(ws + WS_SS3), 1.0f};
            pg8::StaticOrder S; S.init(g.M, g.N, (int)gridDim.x, (int)blockIdx.x); pg8::gemm_phase(lds, g, S, E); }
        else { pg8::Gemm g{(const bf16_t*)(ws + WS_R1), (const bf16_t*)(ws + WS_WD2), T, 1024, FF}; EpiResid<2> E{nullptr, xb, p.out, nullptr, nullptr, 0.5f};
            pg8::StaticOrder S; S.init(g.M, g.N, (int)gridDim.x, (int)blockIdx.x); pg8::gemm_phase(lds, g, S, E); }
        }
    } else if constexpr (PH == 3) {
        if constexpr (PH_MASK & 8) {
        ab_rows(p);
        pg8::Gemm g{(const bf16_t*)(ws + WS_X), (const bf16_t*)(ws + WS_WIN), T, 3584, 1024};
        pg8::StaticOrder S; S.init(g.M, g.N, (int)gridDim.x, (int)blockIdx.x);
        EpiInProj E{(bf16_t*)(ws + WS_R1), (bf16_t*)(ws + WS_O), (const LAS float*)(lds + RT_OFF)};
        fill_row_scales(S, (const float*)(ws + WS_SS2), (LAS float*)(lds + RT_OFF));
        pg8::gemm_phase(lds, g, S, E);
        if constexpr (REP & 8) { ab_rows(p); pg8::gemm_phase(lds, g, S, E); } }
    } else if constexpr (PH == 4) {
        if constexpr (PH_MASK & 16) for (int rep = 0; rep < ((REP & 16) ? 2 : 1); ++rep) for (int it = blockIdx.x; it < 1024; it += gridDim.x) g1_item(p, lds, it);
        if constexpr (PH_MASK & 32) for (int rep = 0; rep < ((REP & 32) ? 2 : 1); ++rep) for (int it = blockIdx.x; it < 1024; it += gridDim.x) moba_prep_item(p, lds, it, (REP & 32) && rep == 0);
    } else if constexpr (PH == 5) {
        if constexpr (REP & 128) { LAS int* slot = (LAS int*)(lds + 119616); unsigned* ctr = (unsigned*)(ws + WS_CTR) + 1;
            for (;;) { if (threadIdx.x == 0) *slot = (int)atomicAdd(ctr, 1u); __syncthreads(); const int item = *slot; __syncthreads(); if (item >= 1024) break; moba_attn_item(p, lds, item, true); } }
        if constexpr (REP & 64) for (int bh = blockIdx.x; bh < 32; bh += gridDim.x) gdn_scan<(REP >> 8) & 7>(p, lds, bh);
        if constexpr (PH_MASK & 64) for (int bh = blockIdx.x; bh < 32; bh += gridDim.x) gdn_scan<0>(p, lds, bh);
        if constexpr (PH_MASK & 128) {
        LAS int* slot = (LAS int*)(lds + 119616);
        unsigned* ctr = (unsigned*)(ws + WS_CTR);
        const int nstat = (int)gridDim.x > 32 ? (int)gridDim.x - 32 : 0;
        bool first = (int)blockIdx.x >= 32;
        for (;;) {
            if (threadIdx.x == 0) *slot = first ? (int)blockIdx.x - 32 : nstat + (int)atomicAdd(ctr, 1u);
            first = false;
            __syncthreads();
            const int item = *slot;
            __syncthreads();
            if (item >= 1024) break;
            moba_attn_item(p, lds, item);
        } }
    }
}
__global__ void __launch_bounds__(512, 2) hymba_mega(Params p) {
    extern __shared__ __attribute__((aligned(16))) unsigned char shm[];
    LAS unsigned char* lds = (LAS unsigned char*)shm;
    cg::grid_group grid = cg::this_grid();
    const int lo = p.ph_lo, hi = p.ph_hi;
    unsigned* bar = (unsigned*)(p.ws + WS_CTR);
    if (hi > 1000) grid.sync();
#define RUN_PH(k) do { if (lo <= (k) && (k) < hi) { run_phase<k>(p, lds); if ((k) + 1 < hi) grid_barrier(bar, (unsigned)((k) + 1 - lo)); } } while (0)
    RUN_PH(0); RUN_PH(1); RUN_PH(2); RUN_PH(3); RUN_PH(4); RUN_PH(5); RUN_PH(6); RUN_PH(7); RUN_PH(8);
#undef RUN_PH
}

extern "C" void kernel_launch(void* const* d_in, const int* in_sizes, int n_in, void* d_out, int out_size, void* d_ws, size_t ws_size, hipStream_t stream) {
    static int grid_blocks = 0;
    if (grid_blocks == 0) {
        if (n_in != 18 || in_sizes[0] != T * DM || out_size != T * DM || ws_size < WS_END) {
            fprintf(stderr, "kernel_launch: unexpected shapes (n_in %d, in0 %d, out %d, ws %zu, need %zu)\n", n_in, n_in > 0 ? in_sizes[0] : -1, out_size, ws_size, (size_t)WS_END);
            grid_blocks = -1; return; }
        int dev = 0, cus = 0, per_cu = 0;
        hipGetDevice(&dev);
        hipDeviceGetAttribute(&cus, hipDeviceAttributeMultiprocessorCount, dev);
        if (hipFuncSetAttribute((const void*)hymba_mega, hipFuncAttributeMaxDynamicSharedMemorySize, LDS_BYTES) != hipSuccess) { fprintf(stderr, "kernel_launch: hipFuncSetAttribute failed\n"); grid_blocks = -1; return; }
        if (hipOccupancyMaxActiveBlocksPerMultiprocessor(&per_cu, (const void*)hymba_mega, 512, LDS_BYTES) != hipSuccess || per_cu < 1) { fprintf(stderr, "kernel_launch: occupancy query says %d\n", per_cu); (void)hipGetLastError(); per_cu = 1; }
        grid_blocks = cus * (per_cu > 1 ? 1 : per_cu);
        if (grid_blocks < 1) grid_blocks = 256;
    }
    if (grid_blocks < 0) return;
    if (hipMemsetAsync((char*)d_ws + WS_CTR, 0, 4096, stream) != hipSuccess) { fprintf(stderr, "kernel_launch: hipMemsetAsync failed\n"); return; }
    Params p{};
    for (int i = 0; i < 18; ++i) p.in[i] = (const float*)d_in[i];
    p.out = (float*)d_out; p.ws = (unsigned char*)d_ws;
#if N_LAUNCH_MODE == 1
    p.ph_lo = 0; p.ph_hi = 9;
    void* args[] = {&p};
    hipError_t e = hipLaunchCooperativeKernel((const void*)hymba_mega, dim3(grid_blocks), dim3(512), args, LDS_BYTES, stream);
    if (e != hipSuccess) fprintf(stderr, "cooperative launch failed: %s (grid %d)\n", hipGetErrorString(e), grid_blocks);
#else
    for (int ph = 0; ph < 9; ++ph) { p.ph_lo = ph; p.ph_hi = ph + 1; hipLaunchKernelGGL(hymba_mega, dim3(grid_blocks), dim3(512), LDS_BYTES, stream, p); }
#endif
}
```

```cpp
#include <hip/hip_runtime.h>
#include <hip/hip_cooperative_groups.h>
#include <cstdio>
namespace cg = cooperative_groups;

#define LAS __attribute__((address_space(3)))
typedef unsigned short bf16_t;
typedef short bf16x8 __attribute__((ext_vector_type(8)));
typedef float f32x4 __attribute__((ext_vector_type(4)));
typedef float f32x2 __attribute__((ext_vector_type(2)));
typedef unsigned u32x4 __attribute__((ext_vector_type(4)));
typedef unsigned u32x2 __attribute__((ext_vector_type(2)));
typedef __bf16 bf16x2_t __attribute__((ext_vector_type(2)));

#ifndef PH_MASK
#define PH_MASK 0xfff
#endif
#ifndef REP
#define REP 0
#endif
#ifndef N_LAUNCH_MODE
#define N_LAUNCH_MODE 1
#endif

constexpr int T = 32768, DM = 1024, FF = 2816, SEQ = 4096;
constexpr float EPS = 1e-6f;
constexpr int LDS_BYTES = 159744;
constexpr int PA_LD = 2560;
constexpr size_t WS_X = 0;
constexpr size_t WS_R1 = WS_X + (size_t)T * 1024 * 2;
constexpr size_t WS_O = WS_R1 + (size_t)T * FF * 2;
constexpr size_t WS_WN = WS_O + (size_t)T * 1024 * 2;
constexpr size_t WS_QD = WS_WN + (size_t)2048 * 8192 * 2;
constexpr size_t WS_KD = WS_QD + (size_t)2048 * 8192 * 2;
constexpr size_t WS_US = WS_KD + (size_t)2048 * 8192 * 2;
constexpr size_t WS_AI = WS_US + (size_t)2048 * 8192 * 2;
constexpr size_t WS_WGU1 = WS_AI + (size_t)2048 * 4096 * 2;
constexpr size_t WS_WD1 = WS_WGU1 + (size_t)5632 * 1024 * 2;
constexpr size_t WS_WGU2 = WS_WD1 + (size_t)1024 * FF * 2;
constexpr size_t WS_WD2 = WS_WGU2 + (size_t)5632 * 1024 * 2;
constexpr size_t WS_WIN = WS_WD2 + (size_t)1024 * FF * 2;
constexpr size_t WS_WOUT = WS_WIN + (size_t)3584 * 1024 * 2;
constexpr size_t WS_WAB = WS_WOUT + (size_t)1024 * 1024 * 2;
constexpr size_t WS_SS1 = WS_WAB + 16 * 1024 * 2;
constexpr size_t WS_SS2 = WS_SS1 + (size_t)T * 4;
constexpr size_t WS_SS3 = WS_SS2 + (size_t)T * 4;
constexpr size_t WS_AB = WS_SS3 + (size_t)T * 4;
constexpr size_t WS_KMEAN = WS_AB + (size_t)T * 8 * 4;
constexpr size_t WS_GLAST = WS_KMEAN + (size_t)8 * 8 * 16 * 64 * 4;
constexpr size_t WS_CTR = WS_GLAST + 2048 * 4;
constexpr size_t WS_END = WS_CTR + 4096;
constexpr size_t X_VT = (size_t)T * 512 * 2;

struct Params {
    const float* in[18];
    float* out;
    unsigned char* ws;
    int ph_lo, ph_hi;
};
enum { I_X = 0, I_F1N, I_F1G, I_F1U, I_F1D, I_MIXN, I_WIN, I_CONV, I_ALOG, I_DTB, I_ONORM, I_QNORM, I_KNORM, I_WOUT, I_F2N, I_F2G, I_F2U, I_F2D };

__device__ __forceinline__ unsigned pk2(float a, float b) { f32x2 v = {a, b}; bf16x2_t r = __builtin_convertvector(v, bf16x2_t); return __builtin_bit_cast(unsigned, r); }
__device__ __forceinline__ float bf2f(bf16_t h) { return __uint_as_float((unsigned)h << 16); }
__device__ __forceinline__ float bflo(unsigned w) { return __uint_as_float(w << 16); }
__device__ __forceinline__ float bfhi(unsigned w) { return __uint_as_float(w & 0xffff0000u); }
__device__ __forceinline__ bf16_t f2bf(float a) { return (bf16_t)(pk2(a, 0.f) & 0xffffu); }
__device__ __forceinline__ float fast_sigmoid(float g) { return __builtin_amdgcn_rcpf(1.f + __builtin_amdgcn_exp2f(-1.44269504f * g)); }
__device__ __forceinline__ float silu_f(float g) { return g * fast_sigmoid(g); }
__device__ __forceinline__ bf16x8 pack8(const f32x4& a, const f32x4& b) { u32x4 p = {pk2(a[0], a[1]), pk2(a[2], a[3]), pk2(b[0], b[1]), pk2(b[2], b[3])}; return __builtin_bit_cast(bf16x8, p); }
#define MFMA16(a, b, c) __builtin_amdgcn_mfma_f32_16x16x32_bf16((a), (b), (c), 0, 0, 0)
__device__ __forceinline__ int pos32(int a) { return 8 * ((a >> 2) & 3) + 4 * (a >> 4) + (a & 3); }
__device__ __forceinline__ int act32(int p) { return 16 * ((p >> 2) & 1) + 4 * (p >> 3) + (p & 3); }

namespace pg8 {
constexpr int BM = 256, BK = 64, HALF = 128, HTB = HALF * BK * 2, STAGE_BYTES = 8 * HTB, NXCD = 8, WGM = 8;
__host__ __device__ __forceinline__ int lds_byte(int r, int c) { const int st = (r >> 4) * 2 + (c >> 5), rr = r & 15, cc = c & 31, ob = rr * 64 + cc * 2; return st * 1024 + (ob ^ (((ob >> 9) & 1) << 5)); }
__host__ __device__ __forceinline__ void stage_rc(int b, int& R, int& C) { const int st = b / 1024, sb = b % 1024, swz = sb ^ (((sb >> 9) & 1) << 5); R = (st >> 1) * 16 + swz / 64; C = (st & 1) * 32 + (swz % 64) / 2; }
__host__ __device__ __forceinline__ int perm32(int rho) { const int n = rho >> 4, i = rho & 15; return 8 * (i >> 2) + 4 * n + (i & 3); }
struct Unit { int pm, pn; };
struct Gemm { const bf16_t* A; const bf16_t* Bt; int M, N, K; };
struct StaticOrder {
    int nM, nN, nwg, G, c;
    __device__ void init(int M, int N, int G_, int c_) { nM = M / BM; nN = N / BM; nwg = nM * nN; G = G_; c = c_; }
    __device__ bool next(int i, Unit& u) const {
        const long L = (long)i * G + c; if (L >= nwg) return false;
        int wgid = (int)L; { const int q = nwg / NXCD, r = nwg % NXCD, xcd = wgid % NXCD, off = wgid / NXCD; wgid = (xcd < r ? xcd * (q + 1) : r * (q + 1) + (xcd - r) * q) + off; }
        const int nig = WGM * nN, gid = wgid / nig, fm = gid * WGM, gsz = (nM - fm) < WGM ? (nM - fm) : WGM;
        u.pm = fm + ((wgid % nig) % gsz); u.pn = (wgid % nig) / gsz; return true;
    }
};
template <class Epi>
__device__ __forceinline__ void gemm_phase(LAS unsigned char* lds, const Gemm g, const StaticOrder& S, const Epi& E) {
    const int tid = threadIdx.x, wid = __builtin_amdgcn_readfirstlane(tid >> 6), lane = tid & 63, wr = wid >> 2, wc = wid & 3, fr = lane & 15, fq = lane >> 4;
    const int K = g.K, nt = K / BK;
    unsigned voffA[2], voffB[2];
#pragma unroll
    for (int i = 0; i < 2; ++i) { int R, C; stage_rc(tid * 16 + i * 8192, R, C); const int Rb = (R & ~31) + perm32(R & 31);
        voffA[i] = (unsigned)(R * K + C) * 2u; voffB[i] = (unsigned)(Rb * K + C) * 2u; }
    const size_t kstep = (size_t)(BK * 2);
    const size_t hstep = (size_t)HALF * K * 2;
    const size_t tstep = 2 * hstep;
    const unsigned ldsw = (unsigned)wid * 1024u;
    const int aoff = lds_byte(wr * 64 + fr, fq * 8), boff = lds_byte(wc * 32 + fr, fq * 8);
#define PG8_SA(b, h) (((b) * 2 + (h)) * HTB)
#define PG8_SB(b, h) ((4 + (b) * 2 + (h)) * HTB)
#define PG8_STAGE(bufoff, gbase, voff) do { _Pragma("unroll") for (int _i = 0; _i < 2; ++_i) \
        __builtin_amdgcn_global_load_lds((const unsigned*)((const char*)(gbase) + (voff)[_i]), (LAS unsigned*)(lds + (bufoff) + ldsw + _i * 8192), 16, 0, 0); } while (0)
#define PG8_LDA(dst, b, h) do { _Pragma("unroll") for (int m = 0; m < 4; ++m) _Pragma("unroll") for (int k = 0; k < 2; ++k) dst[m][k] = *(const LAS bf16x8*)(lds + PG8_SA(b, h) + aoff + m * 2048 + k * 1024); } while (0)
#define PG8_LDB(dst, b, h) do { _Pragma("unroll") for (int n = 0; n < 2; ++n) _Pragma("unroll") for (int k = 0; k < 2; ++k) dst[n][k] = *(const LAS bf16x8*)(lds + PG8_SB(b, h) + boff + n * 2048 + k * 1024); } while (0)
#define PG8_MMA(ai, bj, At, Bt) do { __builtin_amdgcn_s_setprio(1); _Pragma("unroll") for (int m = 0; m < 4; ++m) _Pragma("unroll") for (int n = 0; n < 2; ++n) _Pragma("unroll") for (int k = 0; k < 2; ++k) \
        acc[ai][bj][m][n] = __builtin_amdgcn_mfma_f32_16x16x32_bf16(Bt[n][k], At[m][k], acc[ai][bj][m][n], 0, 0, 0); __builtin_amdgcn_s_setprio(0); } while (0)
#define PG8_WAIT_V(n) asm volatile("s_waitcnt vmcnt(" #n ")" ::: "memory")
#define PG8_WAIT_L(n) asm volatile("s_waitcnt lgkmcnt(" #n ")" ::: "memory")
#define PG8_BAR __builtin_amdgcn_s_barrier()
#define PG8_SCHED __builtin_amdgcn_sched_barrier(0)
    Unit cur, nxt; int ui = 0;
    if (!S.next(0, cur)) return;
    f32x4 acc[2][2][4][2];
#pragma unroll
    for (int a = 0; a < 2; ++a)
#pragma unroll
        for (int b = 0; b < 2; ++b)
#pragma unroll
            for (int m = 0; m < 4; ++m)
#pragma unroll
                for (int n = 0; n < 2; ++n) acc[a][b][m][n] = (f32x4){0.f, 0.f, 0.f, 0.f};
    bf16x8 At[4][2], B0[2][2], B1[2][2];
    const char* cA = (const char*)g.A + (size_t)cur.pm * tstep; const char* cB = (const char*)g.Bt + (size_t)cur.pn * tstep;
    PG8_STAGE(PG8_SB(0, 0), cB, voffB); PG8_STAGE(PG8_SA(0, 0), cA, voffA); PG8_STAGE(PG8_SB(0, 1), cB + hstep, voffB); PG8_STAGE(PG8_SA(0, 1), cA + hstep, voffA);
    if (wr == 1) PG8_BAR;
    PG8_WAIT_V(4); PG8_BAR;
    PG8_STAGE(PG8_SB(1, 0), cB + kstep, voffB); PG8_STAGE(PG8_SA(1, 0), cA + kstep, voffA); PG8_STAGE(PG8_SB(1, 1), cB + hstep + kstep, voffB);
    PG8_WAIT_V(6); PG8_BAR;
    for (;;) {
        const bool has_next = S.next(ui + 1, nxt);
        const char* nA = has_next ? (const char*)g.A + (size_t)nxt.pm * tstep : cA; const char* nB = has_next ? (const char*)g.Bt + (size_t)nxt.pn * tstep : cB;
        for (int t = 0; t < nt; t += 2) {
            const bool last = (t == nt - 2);
            const char* a1 = cA + (size_t)(t + 1) * kstep;
            const char* a2 = last ? nA : cA + (size_t)(t + 2) * kstep; const char* b2 = last ? nB : cB + (size_t)(t + 2) * kstep;
            const char* a3 = a2 + kstep; const char* b3 = b2 + kstep;
            PG8_LDB(B0, 0, 0); PG8_SCHED; PG8_LDA(At, 0, 0); PG8_STAGE(PG8_SA(1, 1), a1 + hstep, voffA);
            PG8_WAIT_L(8); PG8_BAR; PG8_WAIT_L(0); PG8_MMA(0, 0, At, B0); PG8_BAR; PG8_SCHED;
            PG8_LDB(B1, 0, 1); PG8_STAGE(PG8_SB(0, 0), b2, voffB);
            PG8_BAR; PG8_WAIT_L(0); PG8_MMA(0, 1, At, B1); PG8_BAR;
            PG8_LDA(At, 0, 1); PG8_STAGE(PG8_SA(0, 0), a2, voffA);
            PG8_BAR; PG8_WAIT_L(0); PG8_MMA(1, 0, At, B0); PG8_BAR; PG8_SCHED;
            PG8_STAGE(PG8_SB(0, 1), b2 + hstep, voffB);
            PG8_WAIT_V(6); PG8_BAR; PG8_MMA(1, 1, At, B1); PG8_BAR;
            PG8_LDB(B0, 1, 0); PG8_SCHED; PG8_LDA(At, 1, 0); PG8_STAGE(PG8_SA(0, 1), a2 + hstep, voffA);
            PG8_WAIT_L(8); PG8_BAR; PG8_WAIT_L(0); PG8_MMA(0, 0, At, B0); PG8_BAR; PG8_SCHED;
            PG8_LDB(B1, 1, 1); PG8_STAGE(PG8_SB(1, 0), b3, voffB);
            PG8_BAR; PG8_WAIT_L(0); PG8_MMA(0, 1, At, B1); PG8_BAR;
            PG8_LDA(At, 1, 1); PG8_STAGE(PG8_SA(1, 0), a3, voffA);
            PG8_BAR; PG8_WAIT_L(0); PG8_MMA(1, 0, At, B0); PG8_BAR; PG8_SCHED;
            PG8_STAGE(PG8_SB(1, 1), b3 + hstep, voffB);
            PG8_WAIT_V(6); PG8_BAR; PG8_MMA(1, 1, At, B1); PG8_BAR;
        }
        E(acc, cur, ui, wr, wc, fr, fq);
        if (!has_next) break;
#pragma unroll
        for (int a = 0; a < 2; ++a)
#pragma unroll
            for (int b = 0; b < 2; ++b)
#pragma unroll
                for (int m = 0; m < 4; ++m)
#pragma unroll
                    for (int n = 0; n < 2; ++n) acc[a][b][m][n] = (f32x4){0.f, 0.f, 0.f, 0.f};
        cur = nxt; cA = nA; cB = nB; ++ui;
    }
    PG8_WAIT_V(0);
    if (wr == 0) PG8_BAR;
    PG8_BAR;
#undef PG8_SA
#undef PG8_SB
#undef PG8_STAGE
#undef PG8_LDA
#undef PG8_LDB
#undef PG8_MMA
#undef PG8_WAIT_V
#undef PG8_WAIT_L
#undef PG8_BAR
#undef PG8_SCHED
}
}
using pg8::Unit;

constexpr int RT_OFF = 131072;
template <bool SCALE> struct EpiSwiGLU {
    bf16_t* act; const LAS float* rt;
    __device__ __forceinline__ void operator()(const f32x4 (&acc)[2][2][4][2], const Unit& u, int ui, int wr, int wc, int fr, int fq) const {
        const int row0 = u.pm * 256 + wr * 64 + fr, col0 = u.pn * 128 + wc * 32 + 8 * fq; const LAS float* rtu = rt + ui * 256 + wr * 64 + fr;
        float rs[2][4];
#pragma unroll
        for (int ai = 0; ai < 2; ++ai)
#pragma unroll
            for (int m = 0; m < 4; ++m) rs[ai][m] = SCALE ? rtu[ai * 128 + m * 16] : 1.f;
#pragma unroll
        for (int ai = 0; ai < 2; ++ai)
#pragma unroll
            for (int m = 0; m < 4; ++m) {
                const int row = row0 + ai * 128 + m * 16;
                const float r = rs[ai][m];
                float hv[8];
#pragma unroll
                for (int n = 0; n < 2; ++n)
#pragma unroll
                    for (int j = 0; j < 4; ++j) { const float g = acc[ai][0][m][n][j] * r, up = acc[ai][1][m][n][j] * r; hv[4 * n + j] = silu_f(g) * up; }
                u32x4 w = {pk2(hv[0], hv[1]), pk2(hv[2], hv[3]), pk2(hv[4], hv[5]), pk2(hv[6], hv[7])};
                *(u32x4*)(act + (size_t)row * FF + col0) = w;
            }
    }
};
template <int MODE> struct EpiResid {
    const float* residf; const bf16_t* residb; float* outf; bf16_t* outb; float* ss; float scale;
    __device__ __forceinline__ void operator()(const f32x4 (&acc)[2][2][4][2], const Unit& u, int ui, int wr, int wc, int fr, int fq) const {
        const int row0 = u.pm * 256 + wr * 64 + fr, col0 = u.pn * 256 + wc * 32 + 8 * fq;
#pragma unroll
        for (int ai = 0; ai < 2; ++ai) {
            f32x4 rf[MODE == 0 ? 4 : 1][2][2]; u32x4 rb[MODE == 0 ? 1 : 4][2];
#pragma unroll
            for (int m = 0; m < 4; ++m)
#pragma unroll
                for (int bj = 0; bj < 2; ++bj) { const size_t off = (size_t)(row0 + ai * 128 + m * 16) * 1024 + col0 + bj * 128;
                    if constexpr (MODE == 0) { rf[m][bj][0] = *(const f32x4*)(residf + off); rf[m][bj][1] = *(const f32x4*)(residf + off + 4); }
                    else rb[m][bj] = *(const u32x4*)(residb + off); }
#pragma unroll
            for (int m = 0; m < 4; ++m) {
                const int row = row0 + ai * 128 + m * 16; float sq = 0.f;
#pragma unroll
                for (int bj = 0; bj < 2; ++bj) {
                    const size_t off = (size_t)row * 1024 + col0 + bj * 128;
                    f32x4 r0, r1;
                    if constexpr (MODE == 0) { r0 = rf[m][bj][0]; r1 = rf[m][bj][1]; }
                    else { const u32x4 q = rb[m][bj]; r0 = (f32x4){bflo(q[0]), bfhi(q[0]), bflo(q[1]), bfhi(q[1])}; r1 = (f32x4){bflo(q[2]), bfhi(q[2]), bflo(q[3]), bfhi(q[3])}; }
                    const f32x4 v0 = r0 + scale * acc[ai][bj][m][0], v1 = r1 + scale * acc[ai][bj][m][1];
                    if constexpr (MODE == 2) { *(f32x4*)(outf + off) = v0; *(f32x4*)(outf + off + 4) = v1; }
                    else { u32x4 w = {pk2(v0[0], v0[1]), pk2(v0[2], v0[3]), pk2(v1[0], v1[1]), pk2(v1[2], v1[3])}; *(u32x4*)(outb + off) = w;
                        sq += v0[0] * v0[0] + v0[1] * v0[1] + v0[2] * v0[2] + v0[3] * v0[3] + v1[0] * v1[0] + v1[1] * v1[1] + v1[2] * v1[2] + v1[3] * v1[3]; }
                }
                if constexpr (MODE != 2) { if (ss) { sq += __shfl_xor(sq, 16); sq += __shfl_xor(sq, 32); if (fq == 0) unsafeAtomicAdd(ss + row, sq); } }
            }
        }
    }
};
struct EpiInProj {
    bf16_t* Pa; bf16_t* Pb; const LAS float* rt;
    __device__ __forceinline__ void operator()(const f32x4 (&acc)[2][2][4][2], const Unit& u, int ui, int wr, int wc, int fr, int fq) const {
        const int row0 = u.pm * 256 + wr * 64 + fr, col0 = u.pn * 256 + wc * 32 + 8 * fq;
        const bool toA = u.pn < 10; const LAS float* rtu = rt + ui * 256 + wr * 64 + fr;
#pragma unroll
        for (int ai = 0; ai < 2; ++ai)
#pragma unroll
            for (int m = 0; m < 4; ++m) {
                const int row = row0 + ai * 128 + m * 16;
                const float r = rtu[ai * 128 + m * 16];
#pragma unroll
                for (int bj = 0; bj < 2; ++bj) {
                    const f32x4 v0 = acc[ai][bj][m][0] * r, v1 = acc[ai][bj][m][1] * r;
                    u32x4 w = {pk2(v0[0], v0[1]), pk2(v0[2], v0[3]), pk2(v1[0], v1[1]), pk2(v1[2], v1[3])};
                    const int col = col0 + bj * 128;
                    bf16_t* dst = toA ? Pa + (size_t)row * PA_LD + col : Pb + (size_t)row * 1024 + (col - 2560);
                    *(u32x4*)dst = w;
                }
            }
    }
};

__device__ __forceinline__ float wave_sum(float v) {
#pragma unroll
    for (int o = 1; o < 64; o <<= 1) v += __shfl_xor(v, o);
    return v;
}
__device__ __forceinline__ void transpose_item(const float* src, int ldsrc, int K, int k0, int c0, bf16_t* dst, int r0, const float* gain, LAS float* scr, int lane) {
    float v[32];
    const float* sp = src + (size_t)(k0 + (lane >> 5)) * ldsrc + c0 + (lane & 31);
#pragma unroll
    for (int i = 0; i < 32; ++i) v[i] = sp[(size_t)(2 * i) * ldsrc];
    if (gain) {
#pragma unroll
        for (int i = 0; i < 32; ++i) v[i] *= gain[k0 + 2 * i + (lane >> 5)];
    }
#pragma unroll
    for (int i = 0; i < 32; ++i) scr[(2 * i + (lane >> 5)) * 33 + (lane & 31)] = v[i];
    __builtin_amdgcn_wave_barrier();
    const int c = lane & 7;
#pragma unroll
    for (int j = 0; j < 4; ++j) { const int n = (lane >> 3) + 8 * j; const LAS float* sq = scr + (8 * c) * 33 + n;
        u32x4 o = {pk2(sq[0], sq[33]), pk2(sq[66], sq[99]), pk2(sq[132], sq[165]), pk2(sq[198], sq[231])};
        *(u32x4*)(dst + (size_t)(r0 + n) * K + k0 + 8 * c) = o; }
    __builtin_amdgcn_wave_barrier();
}
__device__ __forceinline__ void phase_prep(const Params& p, LAS unsigned char* lds) {
    const int tid = threadIdx.x, nb = gridDim.x, bid = blockIdx.x, wave = tid >> 6, lane = tid & 63;
    unsigned char* ws = p.ws;
    float* ss1 = (float*)(ws + WS_SS1); float* ss2 = (float*)(ws + WS_SS2); float* ss3 = (float*)(ws + WS_SS3);
    for (int i = bid * 512 + tid; i < T; i += nb * 512) { ss2[i] = 0.f; ss3[i] = 0.f; }
    if (bid == 0 && wave == 1) {
        float gq = fabsf(p.in[I_QNORM][lane]), gk = fabsf(p.in[I_KNORM][lane]);
#pragma unroll
        for (int o = 1; o < 64; o <<= 1) { gq = fmaxf(gq, __shfl_xor(gq, o)); gk = fmaxf(gk, __shfl_xor(gk, o)); }
        if (lane == 0) ((float*)(ws + WS_CTR))[32] = fminf(0.18033688f * 64.f * 1.02f * gq * gk, 60.f);
    }
    { bf16_t* wab = (bf16_t*)(ws + WS_WAB); const float* win = p.in[I_WIN]; const float* gn = p.in[I_MIXN];
      for (int idx = bid * 512 + tid; idx < 16 * 1024; idx += nb * 512) { const int n = idx >> 10, k = idx & 1023;
          wab[idx] = n < 8 ? f2bf(win[(size_t)k * 3592 + 2048 + n] * gn[k]) : (bf16_t)0; } }
    { const float* x = p.in[I_X]; bf16_t* xb = (bf16_t*)(ws + WS_X);
      for (int row = bid * 8 + wave; row < T; row += nb * 8) {
          const f32x4* xr = (const f32x4*)(x + (size_t)row * 1024); f32x4 v[4]; float s = 0.f;
#pragma unroll
          for (int j = 0; j < 4; ++j) { v[j] = xr[lane + 64 * j]; s += v[j][0] * v[j][0] + v[j][1] * v[j][1] + v[j][2] * v[j][2] + v[j][3] * v[j][3]; }
          s = wave_sum(s); if (lane == 0) ss1[row] = s;
          const float rn = rsqrtf(s * (1.f / 1024.f) + EPS);
          u32x2* o = (u32x2*)(xb + (size_t)row * 1024);
#pragma unroll
          for (int j = 0; j < 4; ++j) { u32x2 w = {pk2(v[j][0] * rn, v[j][1] * rn), pk2(v[j][2] * rn, v[j][3] * rn)}; o[lane + 64 * j] = w; }
      } }
    LAS float* scr = (LAS float*)(lds + wave * 8448);
    constexpr int N_GU = 88 * 16, N_D = 16 * 44, N_IN = 56 * 16, N_OUT = 16 * 16, N_ALL = 2 * (N_GU + N_D) + N_IN + N_OUT;
    for (int wi = bid * 8 + wave; wi < 2 * N_ALL; wi += nb * 8) {
        int r = wi >> 1; const int hf = (wi & 1) * 32;
        if (r < 2 * N_GU) { const int f = r / N_GU; r -= f * N_GU; const int rt = r >> 4, kt = r & 15, r0 = rt * 64;
            const int pn = r0 >> 8, bj = (r0 >> 7) & 1, rr = r0 & 127;
            const float* src = bj ? p.in[f ? I_F2U : I_F1U] : p.in[f ? I_F2G : I_F1G];
            transpose_item(src, FF, 1024, kt * 64, pn * 128 + rr + hf, (bf16_t*)(ws + (f ? WS_WGU2 : WS_WGU1)), r0 + hf, p.in[f ? I_F2N : I_F1N], scr, lane); continue; }
        r -= 2 * N_GU;
        if (r < 2 * N_D) { const int f = r / N_D; r -= f * N_D; const int rt = r / 44, kt = r % 44;
            transpose_item(p.in[f ? I_F2D : I_F1D], 1024, FF, kt * 64, rt * 64 + hf, (bf16_t*)(ws + (f ? WS_WD2 : WS_WD1)), rt * 64 + hf, nullptr, scr, lane); continue; }
        r -= 2 * N_D;
        if (r < N_IN) { const int rt = r >> 4, kt = r & 15, r0 = rt * 64;
            transpose_item(p.in[I_WIN], 3592, 1024, kt * 64, (r0 < 2048 ? r0 : r0 + 8) + hf, (bf16_t*)(ws + WS_WIN), r0 + hf, p.in[I_MIXN], scr, lane); continue; }
        r -= N_IN;
        { const int rt = r >> 4, kt = r & 15; transpose_item(p.in[I_WOUT], 1024, 1024, kt * 64, rt * 64 + hf, (bf16_t*)(ws + WS_WOUT), rt * 64 + hf, nullptr, scr, lane); }
    }
}

__device__ __forceinline__ void ab_rows(const Params& p) {
    const int tid = threadIdx.x, wave = tid >> 6, lane = tid & 63, fr = lane & 15, fq = lane >> 4;
    const bf16_t* x1b = (const bf16_t*)(p.ws + WS_X); const bf16_t* wab = (const bf16_t*)(p.ws + WS_WAB);
    const float* ss2 = (const float*)(p.ws + WS_SS2); float* ab = (float*)(p.ws + WS_AB);
    for (int wt = blockIdx.x * 8 + wave; wt < T / 16; wt += gridDim.x * 8) {
        const int row0 = wt * 16;
        const bf16_t* arow = x1b + (size_t)(row0 + fr) * 1024 + fq * 8; const bf16_t* brow = wab + (size_t)fr * 1024 + fq * 8;
        f32x4 acc = {0.f, 0.f, 0.f, 0.f};
#pragma unroll 8
        for (int ks = 0; ks < 32; ++ks) { const bf16x8 a = *(const bf16x8*)(arow + ks * 32), b = *(const bf16x8*)(brow + ks * 32); acc = MFMA16(a, b, acc); }
        if (fr < 8) {
#pragma unroll
            for (int j = 0; j < 4; ++j) { const int row = row0 + 4 * fq + j; ab[(size_t)row * 8 + fr] = acc[j] * rsqrtf(ss2[row] * (1.f / 1024.f) + EPS); }
        }
    }
}

constexpr int G1_HALF = 78080;
__device__ __forceinline__ void g1_item(const Params& p, LAS unsigned char* lds, int item) {
    int tid = threadIdx.x; asm volatile("" : "+v"(tid));
    const int hh = tid >> 8, tl = tid & 255, lane = tid & 63, wv4 = tl >> 6, fr = lane & 15, fq = lane >> 4;
    const int hp = item & 1, n = (item >> 1) & 63, b = item >> 7, h = 2 * hp + hh;
    const int chh = (b * 4 + h) * 64 + n, t0 = b * SEQ + n * 64;
    LAS unsigned char* base = lds + hh * G1_HALF;
    LAS bf16_t* Kb = (LAS bf16_t*)base; LAS bf16_t* Qb = (LAS bf16_t*)(base + 17408); LAS bf16_t* Vb = (LAS bf16_t*)(base + 34816);
    LAS float* Lm = (LAS float*)(base + 52224); LAS bf16_t* Ais = (LAS bf16_t*)(base + 68608);
    LAS float* gc = (LAS float*)(base + 76800); LAS float* beta = gc + 64; LAS float* eg = gc + 128;
    const bf16_t* Pa = (const bf16_t*)(p.ws + WS_R1);
    {
        const int dg = tl & 15, tg = tl >> 4, d0 = 8 * dg;
#pragma unroll
        for (int sec = 0; sec < 3; ++sec) {
            const int col = sec * 512 + h * 128 + d0;
            float w[4][8];
#pragma unroll
            for (int kk = 0; kk < 4; ++kk) { const f32x4 wa = *(const f32x4*)(p.in[I_CONV] + kk * 1536 + col), wb = *(const f32x4*)(p.in[I_CONV] + kk * 1536 + col + 4);
#pragma unroll
                for (int e = 0; e < 4; ++e) { w[kk][e] = wa[e]; w[kk][4 + e] = wb[e]; } }
            u32x4 xr[7];
#pragma unroll
            for (int rr = 0; rr < 7; ++rr) { const int tok = n * 64 + 4 * tg - 3 + rr;
                if (tok >= 0) xr[rr] = *(const u32x4*)(Pa + (size_t)(b * SEQ + tok) * PA_LD + col); else xr[rr] = (u32x4){0u, 0u, 0u, 0u}; }
            LAS bf16_t* dstb = sec == 0 ? Qb : (sec == 1 ? Kb : Vb);
#pragma unroll
            for (int ti = 0; ti < 4; ++ti) {
                float y[8]; float ssq = 0.f;
#pragma unroll
                for (int e = 0; e < 8; ++e) { float a = 0.f;
#pragma unroll
                    for (int kk = 0; kk < 4; ++kk) { const unsigned wd = xr[ti + kk][e >> 1]; a += w[kk][e] * ((e & 1) ? bfhi(wd) : bflo(wd)); }
                    y[e] = silu_f(a); ssq += y[e] * y[e]; }
                if (sec < 2) {
                    ssq += __shfl_xor(ssq, 1); ssq += __shfl_xor(ssq, 2); ssq += __shfl_xor(ssq, 4); ssq += __shfl_xor(ssq, 8);
                    const float rn = rsqrtf(ssq + EPS) * (sec == 0 ? 0.08838834764831845f : 1.f);
#pragma unroll
                    for (int e = 0; e < 8; ++e) y[e] *= rn;
                }
                u32x4 o = {pk2(y[0], y[1]), pk2(y[2], y[3]), pk2(y[4], y[5]), pk2(y[6], y[7])};
                *(LAS u32x4*)(dstb + (4 * tg + ti) * 136 + d0) = o;
            }
        }
    }
    if (tl < 64) {
        const int i = tl; const float* ab = (const float*)(p.ws + WS_AB);
        const float a = ab[(size_t)(t0 + i) * 8 + h], bb = ab[(size_t)(t0 + i) * 8 + 4 + h];
        const float A = expf(p.in[I_ALOG][h]); const float xx = a + p.in[I_DTB][h];
        const float sp = xx > 20.f ? xx : log1pf(expf(xx));
        float g = -A * sp;
#pragma unroll
        for (int off = 1; off < 64; off <<= 1) { const float t = __shfl_up(g, off); if (lane >= off) g += t; }
        const float bt = 1.f / (1.f + expf(-bb)), egi = expf(g);
        gc[i] = g; beta[i] = bt; eg[i] = egi; eg[64 + i] = bt * egi; eg[128 + i] = expf(__shfl(g, 63) - g);
        if (i == 63) ((float*)(p.ws + WS_GLAST))[chh] = expf(g);
    }
    __syncthreads();
    {
        const int mt = wv4;
#pragma unroll
        for (int nt = 0; nt < 4; ++nt) {
            f32x4 aK = {0.f, 0.f, 0.f, 0.f}, aQ = {0.f, 0.f, 0.f, 0.f};
#pragma unroll
            for (int ks = 0; ks < 4; ++ks) {
                const bf16x8 bk = *(const LAS bf16x8*)(Kb + (16 * nt + fr) * 136 + 32 * ks + 8 * fq);
                const bf16x8 ak = *(const LAS bf16x8*)(Kb + (16 * mt + fr) * 136 + 32 * ks + 8 * fq);
                const bf16x8 aq = *(const LAS bf16x8*)(Qb + (16 * mt + fr) * 136 + 32 * ks + 8 * fq);
                aK = MFMA16(ak, bk, aK); aQ = MFMA16(aq, bk, aQ);
            }
            const int j = 16 * nt + fr; const float gj = gc[j];
#pragma unroll
            for (int jj = 0; jj < 4; ++jj) { const int i = 16 * mt + 4 * fq + jj;
                const float dec = (i >= j) ? expf(gc[i] - gj) : 0.f;
                Lm[i * 64 + j] = (i > j) ? beta[i] * aK[jj] * dec : 0.f;
                Ais[i * 64 + 32 * (j >> 5) + pos32(j & 31)] = f2bf(aQ[jj] * dec); }
        }
    }
    {
        const int i = tl >> 2, g32 = tl & 3; const float sc = eg[i];
        float a[32];
#pragma unroll
        for (int c4 = 0; c4 < 4; ++c4) { const u32x4 v = *(const LAS u32x4*)(Qb + i * 136 + 32 * g32 + 8 * c4);
#pragma unroll
            for (int e = 0; e < 4; ++e) { a[8 * c4 + 2 * e] = bflo(v[e]) * sc; a[8 * c4 + 2 * e + 1] = bfhi(v[e]) * sc; } }
        bf16_t* dq = (bf16_t*)(p.ws + WS_QD) + (size_t)chh * 8192 + i * 128 + 32 * g32;
#pragma unroll
        for (int c4 = 0; c4 < 4; ++c4) { u32x4 o;
#pragma unroll
            for (int e = 0; e < 4; ++e) o[e] = pk2(a[act32(8 * c4 + 2 * e)], a[act32(8 * c4 + 2 * e + 1)]);
            *(u32x4*)(dq + 8 * c4) = o; }
    }
    {
        const int d = tl >> 1, tgp = tl & 1; const float gl = gc[63];
        bf16_t* dk = (bf16_t*)(p.ws + WS_KD) + (size_t)chh * 8192 + d * 64 + 32 * tgp;
#pragma unroll
        for (int c4 = 0; c4 < 4; ++c4) { u32x4 o;
#pragma unroll
            for (int e = 0; e < 4; ++e) { const int i0 = 32 * tgp + act32(8 * c4 + 2 * e), i1 = 32 * tgp + act32(8 * c4 + 2 * e + 1);
                o[e] = pk2(bf2f(Kb[i0 * 136 + d]) * expf(gl - gc[i0]), bf2f(Kb[i1 * 136 + d]) * expf(gl - gc[i1])); }
            *(u32x4*)(dk + 8 * c4) = o; }
    }
    __syncthreads();
#pragma unroll
    for (int ii = 0; ii < 2; ++ii) { const int id = tl + 256 * ii; *(u32x4*)((bf16_t*)(p.ws + WS_AI) + (size_t)chh * 4096 + id * 8) = *(const LAS u32x4*)(Ais + id * 8); }
    {
        const int c = tl; f32x2 xp[32];
        const LAS bf16_t* rsrc = c < 128 ? Vb + c : Kb + (c - 128);
        const LAS float* rsc = c < 128 ? beta : eg + 64;
#pragma unroll
        for (int q = 0; q < 32; ++q) xp[q] = (f32x2){0.f, 0.f};
#pragma unroll
        for (int i = 0; i < 64; ++i) {
            f32x2 acc = {rsc[i] * bf2f(rsrc[i * 136]), 0.f};
#pragma unroll
            for (int j4 = 0; j4 < (i + 3) / 4; ++j4) { const f32x4 l = *(const LAS f32x4*)(Lm + i * 64 + 4 * j4);
                acc -= (f32x2){l[0], l[1]} * xp[2 * j4]; if (4 * j4 + 2 < i) acc -= (f32x2){l[2], l[3]} * xp[2 * j4 + 1]; }
            const float xi = acc[0] + acc[1];
            if (i & 1) xp[i >> 1][1] = xi; else xp[i >> 1][0] = xi;
            if ((i & 3) == 3) __builtin_amdgcn_sched_barrier(0);
        }
#define x(i_) xp[(i_) >> 1][(i_) & 1]
        __syncthreads();
        LAS bf16_t* stg = (LAS bf16_t*)base;
        if (c < 128) {
            LAS bf16_t* us = stg + 8192 + (c >> 4) * 1024 + (c & 15) * 4;
#pragma unroll
            for (int mt = 0; mt < 4; ++mt)
#pragma unroll
                for (int q = 0; q < 4; ++q) { const int i = 16 * mt + 4 * q; u32x2 o = {pk2(x(i), x(i + 1)), pk2(x(i + 2), x(i + 3))}; *(LAS u32x2*)(us + mt * 256 + q * 64) = o; }
        } else {
            const int kd = c - 128; LAS bf16_t* wn = stg + 32 * (kd >> 5) + pos32(kd & 31);
#pragma unroll
            for (int i = 0; i < 64; ++i) wn[i * 128] = f2bf(-x(i));
        }
    }
#undef x
    __syncthreads();
    {
        LAS bf16_t* stg = (LAS bf16_t*)base;
        bf16_t* gw = (bf16_t*)(p.ws + WS_WN) + (size_t)chh * 8192; bf16_t* gu = (bf16_t*)(p.ws + WS_US) + (size_t)chh * 8192;
#pragma unroll
        for (int ii = 0; ii < 4; ++ii) { const int id = tl + 256 * ii;
            *(u32x4*)(gw + id * 8) = *(const LAS u32x4*)(stg + id * 8);
            *(u32x4*)(gu + id * 8) = *(const LAS u32x4*)(stg + 8192 + id * 8); }
    }
    __syncthreads();
}

__device__ __forceinline__ void moba_prep_item(const Params& p, LAS unsigned char* lds, int item, bool dry = false) {
    const int tid = threadIdx.x;
    const int h = item & 7, blk = (item >> 3) & 15, b = item >> 7, t0 = b * SEQ + blk * 256;
    LAS float* scr = (LAS float*)lds; LAS bf16_t* vt = (LAS bf16_t*)(lds + 66560); LAS float* part = (LAS float*)(lds + 100352);
    const bf16_t* Pa = (const bf16_t*)(p.ws + WS_R1); bf16_t* O = (bf16_t*)(p.ws + WS_O);
    bf16_t* kn = (bf16_t*)p.out; bf16_t* Vt = (bf16_t*)p.out + (size_t)T * 512;
    {
        const int key = tid >> 1, half = tid & 1;
        const bf16_t* src = O + (size_t)(t0 + key) * 1024 + 512 + h * 64 + half * 32;
        const int kp = 32 * (key >> 5) + pos32(key & 31);
#pragma unroll
        for (int c4 = 0; c4 < 4; ++c4) { const u32x4 v = *(const u32x4*)(src + 8 * c4);
#pragma unroll
            for (int e = 0; e < 4; ++e) { vt[(half * 32 + 8 * c4 + 2 * e) * 264 + kp] = (bf16_t)(v[e] & 0xffffu); vt[(half * 32 + 8 * c4 + 2 * e + 1) * 264 + kp] = (bf16_t)(v[e] >> 16); } }
    }
    __syncthreads();
    {
        const int role = tid >> 8, tok = tid & 255;
        const bf16_t* src = role == 0 ? Pa + (size_t)(t0 + tok) * PA_LD + 2048 + h * 64 : O + (size_t)(t0 + tok) * 1024 + h * 64;
        const float* gain = p.in[role == 0 ? I_QNORM : I_KNORM];
        float v[64]; float ssq = 0.f;
#pragma unroll
        for (int c8 = 0; c8 < 8; ++c8) { const u32x4 w = *(const u32x4*)(src + 8 * c8);
#pragma unroll
            for (int e = 0; e < 4; ++e) { v[8 * c8 + 2 * e] = bflo(w[e]); v[8 * c8 + 2 * e + 1] = bfhi(w[e]); } }
#pragma unroll
        for (int i = 0; i < 64; ++i) ssq += v[i] * v[i];
        const float rn = rsqrtf(ssq * (1.f / 64.f) + EPS);
#pragma unroll
        for (int i = 0; i < 64; ++i) v[i] = v[i] * rn * gain[i];
        const float posf = (float)(blk * 256 + tok);
        const float invf[8] = {1.0f, 0.1939227432012558f, 0.03760603070259094f, 0.007292664609849453f, 0.0014142135623842478f, 0.00027424818836152554f, 5.318296098266728e-05f, 1.0313386155758053e-05f};
#pragma unroll
        for (int i = 0; i < 8; ++i) {
            const float ang = posf * invf[i];
            double rev = (double)ang * 0.15915494309189535; rev -= rint(rev);
            const float sn = __builtin_amdgcn_sinf((float)rev), cs = __builtin_amdgcn_cosf((float)rev);
            const float x1 = v[i], x2 = v[i + 8];
            v[i] = x1 * cs - x2 * sn; v[i + 8] = x2 * cs + x1 * sn;
        }
        bf16_t* dst = role == 0 ? (dry ? (bf16_t*)(p.ws + WS_END) + (size_t)tok * 1024 : O + (size_t)(t0 + tok) * 1024) + 512 + h * 64 : kn + (size_t)(t0 + tok) * 512 + h * 64;
#pragma unroll
        for (int c8 = 0; c8 < 8; ++c8) { u32x4 w = {pk2(v[8 * c8], v[8 * c8 + 1]), pk2(v[8 * c8 + 2], v[8 * c8 + 3]), pk2(v[8 * c8 + 4], v[8 * c8 + 5]), pk2(v[8 * c8 + 6], v[8 * c8 + 7])};
            *(u32x4*)(dst + 8 * c8) = w; }
        if (role == 1) {
#pragma unroll
            for (int i = 0; i < 64; ++i) scr[tok * 65 + i] = v[i];
        }
    }
    __syncthreads();
    if (tid < 256) { const int d = tid & 63, pt = tid >> 6; float s = 0.f;
        for (int r = 0; r < 64; ++r) s += scr[(64 * pt + r) * 65 + d];
        part[pt * 64 + d] = s; }
#pragma unroll
    for (int ii = 0; ii < 4; ++ii) { const int id = tid + 512 * ii, d = id >> 5, cc = id & 31;
        *(u32x4*)(Vt + ((size_t)((b * 8 + h) * 16 + blk) * 64 + d) * 256 + cc * 8) = *(const LAS u32x4*)(vt + d * 264 + cc * 8); }
    __syncthreads();
    if (tid < 64) ((float*)(p.ws + WS_KMEAN))[((size_t)((b * 8 + h) * 16) + blk) * 64 + tid] = (part[tid] + part[64 + tid] + part[128 + tid] + part[192 + tid]) * (1.f / 256.f);
    __syncthreads();
}

__device__ __forceinline__ float row16_sum(float v) {
    v += __builtin_bit_cast(float, __builtin_amdgcn_update_dpp(0, __builtin_bit_cast(int, v), 0xB1, 0xF, 0xF, true));
    v += __builtin_bit_cast(float, __builtin_amdgcn_update_dpp(0, __builtin_bit_cast(int, v), 0x4E, 0xF, 0xF, true));
    v += __builtin_bit_cast(float, __builtin_amdgcn_update_dpp(0, __builtin_bit_cast(int, v), 0x141, 0xF, 0xF, true));
    v += __builtin_bit_cast(float, __builtin_amdgcn_update_dpp(0, __builtin_bit_cast(int, v), 0x140, 0xF, 0xF, true));
    return v;
}
template <int DRY>
__device__ __forceinline__ void gdn_scan(const Params& p, LAS unsigned char* lds, int bh) {
    const int tid = threadIdx.x, wv = __builtin_amdgcn_readfirstlane(tid >> 6), lane = tid & 63, fr = lane & 15, fq = lane >> 4;
    const int b = bh >> 2, h = bh & 3;
    const bool cw = wv < 4; const int w4 = wv & 3, tid2 = tid & 255;
    constexpr int W_OFF = 0, Q_OFF = 16384, K_OFF = 32768, A_OFF = 49152, BUF = 57344, OT_OFF = 2 * BUF, RED_OFF = OT_OFF + 2 * 16384;
    LAS float* red = (LAS float*)(lds + RED_OFF);
    const bf16_t* Wn = (const bf16_t*)(p.ws + WS_WN); const bf16_t* Qd = (const bf16_t*)(p.ws + WS_QD); const bf16_t* Kd = (const bf16_t*)(p.ws + WS_KD);
    const bf16_t* Ai = (const bf16_t*)(p.ws + WS_AI); const bf16_t* Us = (const bf16_t*)(p.ws + WS_US); const float* glast = (const float*)(p.ws + WS_GLAST);
    const bf16_t* Pa = (const bf16_t*)(p.ws + WS_R1); bf16_t* O = (bf16_t*)(p.ws + WS_O);
    f32x4 S[8][2];
#pragma unroll
    for (int i = 0; i < 8; ++i) { S[i][0] = (f32x4){0.f, 0.f, 0.f, 0.f}; S[i][1] = (f32x4){0.f, 0.f, 0.f, 0.f}; }
    const int fcc = tid2 & 15;
    LAS float* gainl = (LAS float*)(lds + RED_OFF + 2048);
    if (tid < 128) gainl[tid] = p.in[I_ONORM][tid];
    u32x2 ru[8]; float gl_next = 0.f;
#pragma unroll
    for (int k = 0; k < 8; ++k) ru[k] = (u32x2){0u, 0u};
    const bf16_t* rub = cw ? Us + ((size_t)bh * 64 * 8 + 2 * w4) * 1024 + lane * 4 : Pa + ((size_t)b * SEQ + (tid2 >> 4)) * PA_LD + 1536 + h * 128 + 8 * fcc;
    const size_t ru_step = cw ? (size_t)8192 : (size_t)64 * PA_LD;
    const int ru_a = cw ? 256 : 16 * PA_LD, ru_b = cw ? 1024 : 4;
#define SCAN_GLOAD(nn, zn, par) do { const size_t chh = (size_t)bh * 64 + ((DRY & 4) ? 0 : (nn)); LAS unsigned char* db = lds + ((par) & 1) * BUF + wv * 1024; \
        int lq = lane; asm volatile("" : "+v"(lq));            \
        _Pragma("unroll") for (int i = 0; i < 2; ++i) { \
            const int r16 = 4 * (wv + 8 * i) + (lq >> 4), c16 = (lq & 15) ^ (r16 & 15); const unsigned gw = (unsigned)(r16 * 128 + c16 * 8); \
            const int r8 = 8 * (wv + 8 * i) + (lq >> 3), c8 = (lq & 7) ^ ((r8 >> 1) & 7); const unsigned gk = (unsigned)(r8 * 64 + c8 * 8); \
            __builtin_amdgcn_global_load_lds((const unsigned*)(Wn + chh * 8192 + gw), (LAS unsigned*)(db + W_OFF + i * 8192), 16, 0, 0); \
            __builtin_amdgcn_global_load_lds((const unsigned*)(Qd + chh * 8192 + gw), (LAS unsigned*)(db + Q_OFF + i * 8192), 16, 0, 0); \
            __builtin_amdgcn_global_load_lds((const unsigned*)(Kd + chh * 8192 + gk), (LAS unsigned*)(db + K_OFF + i * 8192), 16, 0, 0); } \
        { const int r8 = 8 * wv + (lq >> 3), c8 = (lq & 7) ^ ((r8 >> 1) & 7); \
          __builtin_amdgcn_global_load_lds((const unsigned*)(Ai + chh * 4096 + (unsigned)(r8 * 64 + c8 * 8)), (LAS unsigned*)(db + A_OFF), 16, 0, 0); } \
        { const bf16_t* rp = rub + (size_t)(cw ? ((DRY & 4) ? 0 : (nn)) : (zn)) * ru_step; \
          _Pragma("unroll") for (int k = 0; k < 8; ++k) ru[k] = *(const u32x2*)(rp + (k >> 1) * ru_a + (k & 1) * ru_b); } \
        if (cw) gl_next = glast[chh]; } while (0)
#define SCAN_STAGE(nn) do { \
        if (cw) { _Pragma("unroll") for (int mt = 0; mt < 4; ++mt) _Pragma("unroll") for (int ct = 0; ct < 2; ++ct) vn[mt][ct] = (f32x4){bflo(ru[2 * mt + ct][0]), bfhi(ru[2 * mt + ct][0]), bflo(ru[2 * mt + ct][1]), bfhi(ru[2 * mt + ct][1])}; gl = gl_next; } } while (0)
#define SCAN_FINAL(nn) do { const int tq = b * SEQ + (nn) * 64; const LAS float* rd = red + ((nn) & 1) * 256; const LAS unsigned char* ot = lds + OT_OFF + ((nn) & 1) * 16384; \
        _Pragma("unroll") for (int ii = 0; ii < 4; ++ii) { const int row = (tid2 >> 4) + 16 * ii; \
            const float tot = (rd[row] + rd[64 + row]) + (rd[128 + row] + rd[192 + row]); const float rstd = rsqrtf(tot * (1.f / 128.f) + EPS); \
            const u32x4 ov = *(const LAS u32x4*)(ot + row * 256 + ((fcc ^ (2 * ((row >> 2) & 3))) * 16)); const u32x4 zz = {ru[2 * ii][0], ru[2 * ii][1], ru[2 * ii + 1][0], ru[2 * ii + 1][1]}; u32x4 res; \
            const f32x4 g0 = *(const LAS f32x4*)(gainl + 8 * fcc), g1 = *(const LAS f32x4*)(gainl + 8 * fcc + 4); const float fgain[8] = {g0[0], g0[1], g0[2], g0[3], g1[0], g1[1], g1[2], g1[3]}; \
            _Pragma("unroll") for (int e = 0; e < 4; ++e) res[e] = pk2(bflo(ov[e]) * rstd * fgain[2 * e] * silu_f(bflo(zz[e])), bfhi(ov[e]) * rstd * fgain[2 * e + 1] * silu_f(bfhi(zz[e]))); \
            if ((DRY & 1) == 0) *(u32x4*)(O + (size_t)(tq + row) * 1024 + h * 128 + 8 * fcc) = res; else if (res[0] == 0x12345u) O[0] = 1; } } while (0)
    SCAN_GLOAD(0, 0, 0);
    f32x4 vn[4][2]; float gl = 0.f;
    SCAN_STAGE(0);
    for (int n = 0; n < 64; ++n) {
        LAS unsigned char* buf = lds + (n & 1) * BUF;
        asm volatile("s_waitcnt vmcnt(0)" ::: "memory");
        asm volatile("s_waitcnt lgkmcnt(0)" ::: "memory");
        __builtin_amdgcn_s_barrier();
        asm volatile("" ::: "memory");
        if (!cw) SCAN_FINAL(n > 0 ? n - 1 : 0);
        SCAN_GLOAD(n + 1 < 64 ? n + 1 : 63, n, n + 1);
        __builtin_amdgcn_sched_barrier(0);
        if (cw) {
            bf16x8 Sb[4][2];
#pragma unroll
            for (int ks = 0; ks < 4; ++ks) { Sb[ks][0] = pack8(S[2 * ks][0], S[2 * ks + 1][0]); Sb[ks][1] = pack8(S[2 * ks][1], S[2 * ks + 1][1]); }
#pragma unroll
            for (int mt = 0; mt < 4; ++mt)
#pragma unroll
                for (int ks = 0; ks < 4; ++ks) { const bf16x8 a = *(const LAS bf16x8*)(buf + W_OFF + (16 * mt + fr) * 256 + (((4 * ks + fq) ^ fr) * 16));
                    vn[mt][0] = MFMA16(a, Sb[ks][0], vn[mt][0]); vn[mt][1] = MFMA16(a, Sb[ks][1], vn[mt][1]); }
            __builtin_amdgcn_sched_barrier(0);
            bf16x8 vb[2][2];
#pragma unroll
            for (int ct = 0; ct < 2; ++ct) { vb[0][ct] = pack8(vn[0][ct], vn[1][ct]); vb[1][ct] = pack8(vn[2][ct], vn[3][ct]); }
#pragma unroll
            for (int mt = 0; mt < 4; ++mt) { vn[mt][0] = (f32x4){0.f, 0.f, 0.f, 0.f}; vn[mt][1] = (f32x4){0.f, 0.f, 0.f, 0.f};
#pragma unroll
                for (int ks = 0; ks < 4; ++ks) { const bf16x8 a = *(const LAS bf16x8*)(buf + Q_OFF + (16 * mt + fr) * 256 + (((4 * ks + fq) ^ fr) * 16));
                    vn[mt][0] = MFMA16(a, Sb[ks][0], vn[mt][0]); vn[mt][1] = MFMA16(a, Sb[ks][1], vn[mt][1]); }
#pragma unroll
                for (int ks = 0; ks < 2; ++ks) { const bf16x8 a = *(const LAS bf16x8*)(buf + A_OFF + (16 * mt + fr) * 128 + (((4 * ks + fq) ^ (fr >> 1)) * 16));
                    vn[mt][0] = MFMA16(a, vb[ks][0], vn[mt][0]); vn[mt][1] = MFMA16(a, vb[ks][1], vn[mt][1]); } }
            __builtin_amdgcn_sched_barrier(0);
            LAS bf16_t* ot = (LAS bf16_t*)(lds + OT_OFF + (n & 1) * 16384);
#pragma unroll
            for (int mt = 0; mt < 4; ++mt) {
                f32x4 sq = vn[mt][0] * vn[mt][0] + vn[mt][1] * vn[mt][1];
#pragma unroll
                for (int j = 0; j < 4; ++j) { sq[j] = row16_sum(sq[j]);
                    const int row = 16 * mt + 4 * fq + j;
                    ot[row * 128 + ((32 * w4 + fr) ^ (16 * fq))] = f2bf(vn[mt][0][j]);
                    ot[row * 128 + ((32 * w4 + 16 + fr) ^ (16 * fq))] = f2bf(vn[mt][1][j]); }
                if (fr == 0) *(LAS f32x4*)(red + (n & 1) * 256 + w4 * 64 + 16 * mt + 4 * fq) = sq;
            }
                    __builtin_amdgcn_sched_barrier(0);
#pragma unroll
            for (int m8 = 0; m8 < 8; ++m8) { S[m8][0] = S[m8][0] * gl; S[m8][1] = S[m8][1] * gl;
#pragma unroll
                for (int ks = 0; ks < 2; ++ks) { const bf16x8 a = *(const LAS bf16x8*)(buf + K_OFF + (16 * m8 + fr) * 128 + (((4 * ks + fq) ^ (fr >> 1)) * 16));
                    S[m8][0] = MFMA16(a, vb[ks][0], S[m8][0]); S[m8][1] = MFMA16(a, vb[ks][1], S[m8][1]); } }
        }
        SCAN_STAGE(n + 1);
    }
    asm volatile("s_waitcnt vmcnt(0)" ::: "memory");
    __syncthreads();
    if (!cw) SCAN_FINAL(63);
#undef SCAN_FINAL
#undef SCAN_STAGE
#undef SCAN_GLOAD
    __syncthreads();
}

__device__ __forceinline__ void moba_attn_item(const Params& p, LAS unsigned char* lds, int item, bool dry = false) {
    const int tid = threadIdx.x, wv = tid >> 6, lane = tid & 63, fr = lane & 15, fq = lane >> 4;
    const int blk = 15 - (item >> 6), bh = item & 63, b = bh >> 3, h = bh & 7, t0 = b * SEQ + blk * 256;
    constexpr int KT_B = 16384, BUF = 32768;
    LAS float* kml = (LAS float*)(lds + 98304); LAS float* gts = (LAS float*)(lds + 102144); LAS unsigned* sel = (LAS unsigned*)(lds + 118528);
    bf16_t* O = (bf16_t*)(p.ws + WS_O); const bf16_t* kn = (const bf16_t*)p.out; const bf16_t* Vt = (const bf16_t*)p.out + (size_t)T * 512;
    const float* kmean = (const float*)(p.ws + WS_KMEAN) + (size_t)((b * 8 + h) * 16) * 64;
    unsigned kofs[2], vofs[2];
#pragma unroll
    for (int i = 0; i < 2; ++i) { const int pc = wv + 8 * i; const int rk = 8 * pc + (lane >> 3), ck = (lane & 7) ^ ((rk >> 1) & 7); kofs[i] = (unsigned)(rk * 512 + ck * 8);
        const int rv = 4 * pc + (lane >> 4), cv = (lane & 15) ^ (rv & 15); vofs[i] = (unsigned)(rv * 256 + cv * 8); }
    const bf16_t* knh = kn + (size_t)b * SEQ * 512 + h * 64; const bf16_t* vth = Vt + (size_t)((b * 8 + h) * 16) * 16384;
#define ATT_DMA(tix_, par_) do { const int nb_ = (tix_) >> 1, hf_ = (tix_) & 1; LAS unsigned char* db = lds + (par_) * BUF + wv * 1024; \
        _Pragma("unroll") for (int i = 0; i < 2; ++i) { \
            __builtin_amdgcn_global_load_lds((const unsigned*)(knh + (size_t)(nb_ * 256 + hf_ * 128) * 512 + kofs[i]), (LAS unsigned*)(db + i * 8192), 16, 0, 0); \
            __builtin_amdgcn_global_load_lds((const unsigned*)(vth + (size_t)nb_ * 16384 + hf_ * 128 + vofs[i]), (LAS unsigned*)(db + KT_B + i * 8192), 16, 0, 0); } } while (0)
    const int ntiles = 2 * blk + 2;
    ATT_DMA(0, 0); ATT_DMA(1, 1);
    bf16x8 qf[2][2];
#pragma unroll
    for (int nt = 0; nt < 2; ++nt)
#pragma unroll
        for (int ks = 0; ks < 2; ++ks) qf[nt][ks] = *(const bf16x8*)(O + (size_t)(t0 + 32 * wv + 16 * nt + fr) * 1024 + 512 + h * 64 + 32 * ks + 8 * fq);
    if (blk > 3) {
        for (int idx = tid; idx < blk * 64; idx += 512) kml[idx] = kmean[idx];
        __syncthreads();
        {
            const int qi = tid & 255, part = tid >> 8; const bf16_t* src = O + (size_t)(t0 + qi) * 1024 + 512 + h * 64;
            u32x4 qp[8];
#pragma unroll
            for (int c8 = 0; c8 < 8; ++c8) qp[c8] = *(const u32x4*)(src + 8 * c8);
            for (int nb = part; nb < blk; nb += 2) { float s = 0.f;
#pragma unroll
                for (int c8 = 0; c8 < 8; ++c8) { const f32x4 ka = *(const LAS f32x4*)(kml + nb * 64 + 8 * c8), kb = *(const LAS f32x4*)(kml + nb * 64 + 8 * c8 + 4);
                    s += bflo(qp[c8][0]) * ka[0] + bfhi(qp[c8][0]) * ka[1] + bflo(qp[c8][1]) * ka[2] + bfhi(qp[c8][1]) * ka[3]
                       + bflo(qp[c8][2]) * kb[0] + bfhi(qp[c8][2]) * kb[1] + bflo(qp[c8][3]) * kb[2] + bfhi(qp[c8][3]) * kb[3]; }
                gts[qi * 16 + nb] = s; }
        }
        __syncthreads();
        if (tid < 256) {
            float v1 = -INFINITY, v2 = -INFINITY, v3 = -INFINITY; int i1 = 0, i2 = 0, i3 = 0;
            for (int nb = 0; nb < blk; ++nb) { const float g = gts[tid * 16 + nb];
                if (g > v1) { v3 = v2; i3 = i2; v2 = v1; i2 = i1; v1 = g; i1 = nb; }
                else if (g > v2) { v3 = v2; i3 = i2; v2 = g; i2 = nb; }
                else if (g > v3) { v3 = g; i3 = nb; } }
            sel[tid] = (1u << i1) | (1u << i2) | (1u << i3);
        }
    } else { if (tid < 256) sel[tid] = (1u << blk) - 1u; }
    __syncthreads();
    unsigned selm[2]; selm[0] = sel[32 * wv + fr]; selm[1] = sel[32 * wv + 16 + fr];
    float lrun[2] = {0.f, 0.f};
    const float mref = ((const float*)(p.ws + WS_CTR))[32];
    f32x4 oacc[4][2];
#pragma unroll
    for (int dt = 0; dt < 4; ++dt) { oacc[dt][0] = (f32x4){0.f, 0.f, 0.f, 0.f}; oacc[dt][1] = (f32x4){0.f, 0.f, 0.f, 0.f}; }
    int bcur = 0;
    for (int tix = 0; tix < ntiles; ++tix) {
        LAS unsigned char* buf = lds + bcur * BUF;
        asm volatile("s_waitcnt vmcnt(4)" ::: "memory");
        __builtin_amdgcn_s_barrier();
        asm volatile("" ::: "memory");
        { const int nx = tix + 2 < ntiles ? tix + 2 : ntiles - 1; const int bn = bcur == 0 ? 2 : bcur - 1;
          ATT_DMA(nx, bn); }
        const int nb = tix >> 1, half = tix & 1; const bool own = (nb == blk);
        bool active;
        if (own) active = (128 * half <= 32 * wv + 31);
        else active = __any((int)(((selm[0] | selm[1]) >> nb) & 1u)) != 0;
        if (active) {
            f32x4 s[8][2];
#pragma unroll
            for (int kt = 0; kt < 8; ++kt) {
                const bf16x8 k0 = *(const LAS bf16x8*)(buf + (16 * kt + fr) * 128 + ((fq ^ (fr >> 1)) * 16));
                const bf16x8 k1 = *(const LAS bf16x8*)(buf + (16 * kt + fr) * 128 + (((4 + fq) ^ (fr >> 1)) * 16));
#pragma unroll
                for (int nt = 0; nt < 2; ++nt) { f32x4 a = {0.f, 0.f, 0.f, 0.f}; a = MFMA16(k0, qf[nt][0], a); a = MFMA16(k1, qf[nt][1], a); s[kt][nt] = a; }
            }
            constexpr float SC = 0.18033688011112042f;
            if (own) {
                asm volatile("" ::: "memory");
#pragma unroll
                for (int nt = 0; nt < 2; ++nt) { const int qloc = 32 * wv + 16 * nt + fr - 128 * half - 4 * fq;
#pragma unroll
                    for (int kt = 0; kt < 8; ++kt)
#pragma unroll
                        for (int j = 0; j < 4; ++j) s[kt][nt][j] = (16 * kt + j <= qloc) ? s[kt][nt][j] : -INFINITY; }
            }
#pragma unroll
            for (int nt = 0; nt < 2; ++nt) {
                const bool colsel = own || (((selm[nt] >> nb) & 1u) != 0u);
                const float mneg = colsel ? -mref : -INFINITY;
                float ls = 0.f;
#pragma unroll
                for (int kt = 0; kt < 8; ++kt)
#pragma unroll
                    for (int j = 0; j < 4; ++j) { const float pv = __builtin_amdgcn_exp2f(__builtin_fmaf(s[kt][nt][j], SC, mneg)); s[kt][nt][j] = pv; ls += pv; }
                lrun[nt] += ls;
            }
#pragma unroll
            for (int ks = 0; ks < 4; ++ks) {
                const bf16x8 pb0 = pack8(s[2 * ks][0], s[2 * ks + 1][0]), pb1 = pack8(s[2 * ks][1], s[2 * ks + 1][1]);
#pragma unroll
                for (int dt = 0; dt < 4; ++dt) { const bf16x8 vf = *(const LAS bf16x8*)(buf + KT_B + (16 * dt + fr) * 256 + (((4 * ks + fq) ^ fr) * 16));
                    oacc[dt][0] = MFMA16(vf, pb0, oacc[dt][0]); oacc[dt][1] = MFMA16(vf, pb1, oacc[dt][1]); }
            }
        }
        bcur = bcur == 2 ? 0 : bcur + 1;
    }
#undef ATT_DMA
    asm volatile("s_waitcnt vmcnt(0)" ::: "memory");
#pragma unroll
    for (int nt = 0; nt < 2; ++nt) {
        float lt = lrun[nt]; lt += __shfl_xor(lt, 16); lt += __shfl_xor(lt, 32); const float inv = 1.f / lt;
        bf16_t* dst = (dry ? (bf16_t*)(p.ws + WS_END) + (size_t)(32 * wv + 16 * nt + fr) * 1024 : O + (size_t)(t0 + 32 * wv + 16 * nt + fr) * 1024) + 512 + h * 64 + 4 * fq;
#pragma unroll
        for (int dt = 0; dt < 4; ++dt) { u32x2 w = {pk2(oacc[dt][nt][0] * inv, oacc[dt][nt][1] * inv), pk2(oacc[dt][nt][2] * inv, oacc[dt][nt][3] * inv)}; *(u32x2*)(dst + 16 * dt) = w; }
    }
    __syncthreads();
}

__device__ __forceinline__ void grid_barrier(unsigned* ctl, unsigned gen) {
    __syncthreads();
    if (threadIdx.x == 0) {
        __builtin_amdgcn_fence(__ATOMIC_RELEASE, "agent");
        const unsigned G = gridDim.x;
        if ((G & 7u) == 0u) {
            const unsigned gs = G >> 3, g = blockIdx.x & 7u;
            const unsigned old = __hip_atomic_fetch_add(ctl + 128 + 32 * g, 1u, __ATOMIC_RELAXED, __HIP_MEMORY_SCOPE_AGENT);
            if (old + 1u == gs * gen) {
                __builtin_amdgcn_fence(__ATOMIC_ACQ_REL, "agent");
                __hip_atomic_fetch_add(ctl + 64, 1u, __ATOMIC_RELAXED, __HIP_MEMORY_SCOPE_AGENT);
            }
            while (__hip_atomic_load(ctl + 64, __ATOMIC_RELAXED, __HIP_MEMORY_SCOPE_AGENT) < 8u * gen) __builtin_amdgcn_s_sleep(4);
        } else {
            __hip_atomic_fetch_add(ctl + 16, 1u, __ATOMIC_RELAXED, __HIP_MEMORY_SCOPE_AGENT);
            while (__hip_atomic_load(ctl + 16, __ATOMIC_RELAXED, __HIP_MEMORY_SCOPE_AGENT) < G * gen) __builtin_amdgcn_s_sleep(2);
        }
        __builtin_amdgcn_fence(__ATOMIC_ACQUIRE, "agent");
    }
    __syncthreads();
}
__device__ __forceinline__ void fill_row_scales(const pg8::StaticOrder& S, const float* ss, LAS float* rt) {
    const int tid = threadIdx.x;
    if (tid < 256) {
        float t[12];
#pragma unroll
        for (int i = 0; i < 12; ++i) { pg8::Unit u; t[i] = S.next(i, u) ? ss[u.pm * 256 + tid] : 1024.f; }
#pragma unroll
        for (int i = 0; i < 12; ++i) rt[i * 256 + tid] = rsqrtf(t[i] * (1.f / 1024.f) + EPS);
    }
    __syncthreads();
}
template <int PH>
__device__ __forceinline__ void run_phase(const Params& p, LAS unsigned char* lds) {
    unsigned char* ws = p.ws;
    if constexpr (PH == 0) { if constexpr (PH_MASK & 1) { phase_prep(p, lds); if constexpr (REP & 1) { __syncthreads(); phase_prep(p, lds); } } }
    else if constexpr (PH == 1 || PH == 7) {
        if constexpr (PH_MASK & 2) {
        pg8::Gemm g{(const bf16_t*)(ws + WS_X), (const bf16_t*)(ws + (PH == 1 ? WS_WGU1 : WS_WGU2)), T, 5632, 1024};
        pg8::StaticOrder S; S.init(g.M, g.N, (int)gridDim.x, (int)blockIdx.x);
        EpiSwiGLU<(PH == 7)> E{(bf16_t*)(ws + WS_R1), (const LAS float*)(lds + RT_OFF)};
        if constexpr (PH == 7) fill_row_scales(S, (const float*)(ws + WS_SS3), (LAS float*)(lds + RT_OFF));
        pg8::gemm_phase(lds, g, S, E);
        if constexpr ((REP & 2) && PH == 1) pg8::gemm_phase(lds, g, S, E); }
    } else if constexpr (PH == 2 || PH == 6 || PH == 8) {
        if constexpr (PH_MASK & 4) {
        bf16_t* xb = (bf16_t*)(ws + WS_X);
        if constexpr (PH == 2) { pg8::Gemm g{(const bf16_t*)(ws + WS_R1), (const bf16_t*)(ws + WS_WD1), T, 1024, FF}; EpiResid<0> E{p.in[I_X], nullptr, nullptr, xb, (float*)(ws + WS_SS2), 0.5f};
            pg8::StaticOrder S; S.init(g.M, g.N, (int)gridDim.x, (int)blockIdx.x); pg8::gemm_phase(lds, g, S, E);
            if constexpr (REP & 4) { E.ss = nullptr; pg8::gemm_phase(lds, g, S, E); } }
        else if constexpr (PH == 6) { pg8::Gemm g{(const bf16_t*)(ws + WS_O), (const bf16_t*)(ws + WS_WOUT), T, 1024, 1024}; EpiResid<1> E{nullptr, xb, nullptr, xb, (float*)(ws + WS_SS3), 1.0f};
            pg8::StaticOrder S; S.init(g.M, g.N, (int)gridDim.x, (int)blockIdx.x); pg8::gemm_phase(lds, g, S, E); }
        else { pg8::Gemm g{(const bf16_t*)(ws + WS_R1), (const bf16_t*)(ws + WS_WD2), T, 1024, FF}; EpiResid<2> E{nullptr, xb, p.out, nullptr, nullptr, 0.5f};
            pg8::StaticOrder S; S.init(g.M, g.N, (int)gridDim.x, (int)blockIdx.x); pg8::gemm_phase(lds, g, S, E); }
        }
    } else if constexpr (PH == 3) {
        if constexpr (PH_MASK & 8) {
        ab_rows(p);
        pg8::Gemm g{(const bf16_t*)(ws + WS_X), (const bf16_t*)(ws + WS_WIN), T, 3584, 1024};
        pg8::StaticOrder S; S.init(g.M, g.N, (int)gridDim.x, (int)blockIdx.x);
        EpiInProj E{(bf16_t*)(ws + WS_R1), (bf16_t*)(ws + WS_O), (const LAS float*)(lds + RT_OFF)};
        fill_row_scales(S, (const float*)(ws + WS_SS2), (LAS float*)(lds + RT_OFF));
        pg8::gemm_phase(lds, g, S, E);
        if constexpr (REP & 8) { ab_rows(p); pg8::gemm_phase(lds, g, S, E); } }
    } else if constexpr (PH == 4) {
        if constexpr (PH_MASK & 16) for (int rep = 0; rep < ((REP & 16) ? 2 : 1); ++rep) for (int it = blockIdx.x; it < 1024; it += gridDim.x) g1_item(p, lds, it);
        if constexpr (PH_MASK & 32) for (int rep = 0; rep < ((REP & 32) ? 2 : 1); ++rep) for (int it = blockIdx.x; it < 1024; it += gridDim.x) moba_prep_item(p, lds, it, (REP & 32) && rep == 0);
    } else if constexpr (PH == 5) {
        if constexpr (REP & 128) { LAS int* slot = (LAS int*)(lds + 119616); unsigned* ctr = (unsigned*)(ws + WS_CTR) + 1;
            for (;;) { if (threadIdx.x == 0) *slot = (int)atomicAdd(ctr, 1u); __syncthreads(); const int item = *slot; __syncthreads(); if (item >= 1024) break; moba_attn_item(p, lds, item, true); } }
        if constexpr (REP & 64) for (int bh = blockIdx.x; bh < 32; bh += gridDim.x) gdn_scan<(REP >> 8) & 7>(p, lds, bh);
        if constexpr (PH_MASK & 64) for (int bh = blockIdx.x; bh < 32; bh += gridDim.x) gdn_scan<0>(p, lds, bh);
        if constexpr (PH_MASK & 128) {
        LAS int* slot = (LAS int*)(lds + 119616);
        unsigned* ctr = (unsigned*)(ws + WS_CTR);
        const int nstat = (int)gridDim.x > 32 ? (int)gridDim.x - 32 : 0;
        bool first = (int)blockIdx.x >= 32;
        for (;;) {
            if (threadIdx.x == 0) *slot = first ? (int)blockIdx.x - 32 : nstat + (int)atomicAdd(ctr, 1u);
            first = false;
            __syncthreads();
            const int item = *slot;
            __syncthreads();
            if (item >= 1024) break;
            moba_attn_item(p, lds, item);
        } }
    }
}
__global__ void __launch_bounds__(512, 2) hymba_mega(Params p) {
    extern __shared__ __attribute__((aligned(16))) unsigned char shm[];
    LAS unsigned char* lds = (LAS unsigned char*)shm;
    cg::grid_group grid = cg::this_grid();
    const int lo = p.ph_lo, hi = p.ph_hi;
    unsigned* bar = (unsigned*)(p.ws + WS_CTR);
    if (hi > 1000) grid.sync();
#define RUN_PH(k) do { if (lo <= (k) && (k) < hi) { run_phase<k>(p, lds); if ((k) + 1 < hi) grid_barrier(bar, (unsigned)((k) + 1 - lo)); } } while (0)
    RUN_PH(0); RUN_PH(1); RUN_PH(2); RUN_PH(3); RUN_PH(4); RUN_PH(5); RUN_PH(6); RUN_PH(7); RUN_PH(8);
#undef RUN_PH
}

extern "C" void kernel_launch(void* const* d_in, const int* in_sizes, int n_in, void* d_out, int out_size, void* d_ws, size_t ws_size, hipStream_t stream) {
    static int grid_blocks = 0;
    if (grid_blocks == 0) {
        if (n_in != 18 || in_sizes[0] != T * DM || out_size != T * DM || ws_size < WS_END) {
            fprintf(stderr, "kernel_launch: unexpected shapes (n_in %d, in0 %d, out %d, ws %zu, need %zu)\n", n_in, n_in > 0 ? in_sizes[0] : -1, out_size, ws_size, (size_t)WS_END);
            grid_blocks = -1; return; }
        int dev = 0, cus = 0, per_cu = 0;
        hipGetDevice(&dev);
        hipDeviceGetAttribute(&cus, hipDeviceAttributeMultiprocessorCount, dev);
        if (hipFuncSetAttribute((const void*)hymba_mega, hipFuncAttributeMaxDynamicSharedMemorySize, LDS_BYTES) != hipSuccess) { fprintf(stderr, "kernel_launch: hipFuncSetAttribute failed\n"); grid_blocks = -1; return; }
        if (hipOccupancyMaxActiveBlocksPerMultiprocessor(&per_cu, (const void*)hymba_mega, 512, LDS_BYTES) != hipSuccess || per_cu < 1) { fprintf(stderr, "kernel_launch: occupancy query says %d\n", per_cu); (void)hipGetLastError(); per_cu = 1; }
        grid_blocks = cus * (per_cu > 1 ? 1 : per_cu);
        if (grid_blocks < 1) grid_blocks = 256;
    }
    if (grid_blocks < 0) return;
    if (hipMemsetAsync((char*)d_ws + WS_CTR, 0, 4096, stream) != hipSuccess) { fprintf(stderr, "kernel_launch: hipMemsetAsync failed\n"); return; }
    Params p{};
    for (int i = 0; i < 18; ++i) p.in[i] = (const float*)d_in[i];
    p.out = (float*)d_out; p.ws = (unsigned char*)d_ws;
#if N_LAUNCH_MODE == 1
    p.ph_lo = 0; p.ph_hi = 9;
    void* args[] = {&p};
    hipError_t e = hipLaunchCooperativeKernel((const void*)hymba_mega, dim3(grid_blocks), dim3(512), args, LDS_BYTES, stream);
    if (e != hipSuccess) fprintf(stderr, "cooperative launch failed: %s (grid %d)\n", hipGetErrorString(e), grid_blocks);
#else
    for (int ph = 0; ph < 9; ++ph) { p.ph_lo = ph; p.ph_hi = ph + 1; hipLaunchKernelGGL(hymba_mega, dim3(grid_blocks), dim3(512), LDS_BYTES, stream, p); }
#endif
}
```

```cpp
#include <hip/hip_runtime.h>
#include <hip/hip_cooperative_groups.h>
#include <cstdio>
namespace cg = cooperative_groups;

#define LAS __attribute__((address_space(3)))
typedef unsigned short bf16_t;
typedef short bf16x8 __attribute__((ext_vector_type(8)));
typedef float f32x4 __attribute__((ext_vector_type(4)));
typedef float f32x2 __attribute__((ext_vector_type(2)));
typedef unsigned u32x4 __attribute__((ext_vector_type(4)));
typedef unsigned u32x2 __attribute__((ext_vector_type(2)));
typedef __bf16 bf16x2_t __attribute__((ext_vector_type(2)));

#ifndef PH_MASK
#define PH_MASK 0xfff
#endif
#ifndef REP
#define REP 0
#endif
#ifndef N_LAUNCH_MODE
#define N_LAUNCH_MODE 1
#endif

constexpr int T = 32768, DM = 1024, FF = 2816, SEQ = 4096;
constexpr float EPS = 1e-6f;
constexpr int LDS_BYTES = 159744;
constexpr int PA_LD = 2560;
constexpr size_t WS_X = 0;
constexpr size_t WS_R1 = WS_X + (size_t)T * 1024 * 2;
constexpr size_t WS_O = WS_R1 + (size_t)T * FF * 2;
constexpr size_t WS_WN = WS_O + (size_t)T * 1024 * 2;
constexpr size_t WS_QD = WS_WN + (size_t)2048 * 8192 * 2;
constexpr size_t WS_KD = WS_QD + (size_t)2048 * 8192 * 2;
constexpr size_t WS_US = WS_KD + (size_t)2048 * 8192 * 2;
constexpr size_t WS_AI = WS_US + (size_t)2048 * 8192 * 2;
constexpr size_t WS_WGU1 = WS_AI + (size_t)2048 * 4096 * 2;
constexpr size_t WS_WD1 = WS_WGU1 + (size_t)5632 * 1024 * 2;
constexpr size_t WS_WGU2 = WS_WD1 + (size_t)1024 * FF * 2;
constexpr size_t WS_WD2 = WS_WGU2 + (size_t)5632 * 1024 * 2;
constexpr size_t WS_WIN = WS_WD2 + (size_t)1024 * FF * 2;
constexpr size_t WS_WOUT = WS_WIN + (size_t)3584 * 1024 * 2;
constexpr size_t WS_WAB = WS_WOUT + (size_t)1024 * 1024 * 2;
constexpr size_t WS_SS1 = WS_WAB + 16 * 1024 * 2;
constexpr size_t WS_SS2 = WS_SS1 + (size_t)T * 4;
constexpr size_t WS_SS3 = WS_SS2 + (size_t)T * 4;
constexpr size_t WS_AB = WS_SS3 + (size_t)T * 4;
constexpr size_t WS_KMEAN = WS_AB + (size_t)T * 8 * 4;
constexpr size_t WS_GLAST = WS_KMEAN + (size_t)8 * 8 * 16 * 64 * 4;
constexpr size_t WS_CTR = WS_GLAST + 2048 * 4;
constexpr size_t WS_END = WS_CTR + 4096;
constexpr size_t X_VT = (size_t)T * 512 * 2;

struct Params {
    const float* in[18];
    float* out;
    unsigned char* ws;
    int ph_lo, ph_hi;
};
enum { I_X = 0, I_F1N, I_F1G, I_F1U, I_F1D, I_MIXN, I_WIN, I_CONV, I_ALOG, I_DTB, I_ONORM, I_QNORM, I_KNORM, I_WOUT, I_F2N, I_F2G, I_F2U, I_F2D };

__device__ __forceinline__ unsigned pk2(float a, float b) { f32x2 v = {a, b}; bf16x2_t r = __builtin_convertvector(v, bf16x2_t); return __builtin_bit_cast(unsigned, r); }
__device__ __forceinline__ float bf2f(bf16_t h) { return __uint_as_float((unsigned)h << 16); }
__device__ __forceinline__ float bflo(unsigned w) { return __uint_as_float(w << 16); }
__device__ __forceinline__ float bfhi(unsigned w) { return __uint_as_float(w & 0xffff0000u); }
__device__ __forceinline__ bf16_t f2bf(float a) { return (bf16_t)(pk2(a, 0.f) & 0xffffu); }
__device__ __forceinline__ float fast_sigmoid(float g) { return __builtin_amdgcn_rcpf(1.f + __builtin_amdgcn_exp2f(-1.44269504f * g)); }
__device__ __forceinline__ float silu_f(float g) { return g * fast_sigmoid(g); }
__device__ __forceinline__ bf16x8 pack8(const f32x4& a, const f32x4& b) { u32x4 p = {pk2(a[0], a[1]), pk2(a[2], a[3]), pk2(b[0], b[1]), pk2(b[2], b[3])}; return __builtin_bit_cast(bf16x8, p); }
#define MFMA16(a, b, c) __builtin_amdgcn_mfma_f32_16x16x32_bf16((a), (b), (c), 0, 0, 0)
__device__ __forceinline__ int pos32(int a) { return 8 * ((a >> 2) & 3) + 4 * (a >> 4) + (a & 3); }
__device__ __forceinline__ int act32(int p) { return 16 * ((p >> 2) & 1) + 4 * (p >> 3) + (p & 3); }

namespace pg8 {
constexpr int BM = 256, BK = 64, HALF = 128, HTB = HALF * BK * 2, STAGE_BYTES = 8 * HTB, NXCD = 8, WGM = 8;
__host__ __device__ __forceinline__ int lds_byte(int r, int c) { const int st = (r >> 4) * 2 + (c >> 5), rr = r & 15, cc = c & 31, ob = rr * 64 + cc * 2; return st * 1024 + (ob ^ (((ob >> 9) & 1) << 5)); }
__host__ __device__ __forceinline__ void stage_rc(int b, int& R, int& C) { const int st = b / 1024, sb = b % 1024, swz = sb ^ (((sb >> 9) & 1) << 5); R = (st >> 1) * 16 + swz / 64; C = (st & 1) * 32 + (swz % 64) / 2; }
__host__ __device__ __forceinline__ int perm32(int rho) { const int n = rho >> 4, i = rho & 15; return 8 * (i >> 2) + 4 * n + (i & 3); }
struct Unit { int pm, pn; };
struct Gemm { const bf16_t* A; const bf16_t* Bt; int M, N, K; };
struct StaticOrder {
    int nM, nN, nwg, G, c;
    __device__ void init(int M, int N, int G_, int c_) { nM = M / BM; nN = N / BM; nwg = nM * nN; G = G_; c = c_; }
    __device__ bool next(int i, Unit& u) const {
        const long L = (long)i * G + c; if (L >= nwg) return false;
        int wgid = (int)L; { const int q = nwg / NXCD, r = nwg % NXCD, xcd = wgid % NXCD, off = wgid / NXCD; wgid = (xcd < r ? xcd * (q + 1) : r * (q + 1) + (xcd - r) * q) + off; }
        const int nig = WGM * nN, gid = wgid / nig, fm = gid * WGM, gsz = (nM - fm) < WGM ? (nM - fm) : WGM;
        u.pm = fm + ((wgid % nig) % gsz); u.pn = (wgid % nig) / gsz; return true;
    }
};
template <class Epi>
__device__ __forceinline__ void gemm_phase(LAS unsigned char* lds, const Gemm g, const StaticOrder& S, const Epi& E) {
    const int tid = threadIdx.x, wid = __builtin_amdgcn_readfirstlane(tid >> 6), lane = tid & 63, wr = wid >> 2, wc = wid & 3, fr = lane & 15, fq = lane >> 4;
    const int K = g.K, nt = K / BK;
    unsigned voffA[2], voffB[2];
#pragma unroll
    for (int i = 0; i < 2; ++i) { int R, C; stage_rc(tid * 16 + i * 8192, R, C); const int Rb = (R & ~31) + perm32(R & 31);
        voffA[i] = (unsigned)(R * K + C) * 2u; voffB[i] = (unsigned)(Rb * K + C) * 2u; }
    const size_t kstep = (size_t)(BK * 2);
    const size_t hstep = (size_t)HALF * K * 2;
    const size_t tstep = 2 * hstep;
    const unsigned ldsw = (unsigned)wid * 1024u;
    const int aoff = lds_byte(wr * 64 + fr, fq * 8), boff = lds_byte(wc * 32 + fr, fq * 8);
#define PG8_SA(b, h) (((b) * 2 + (h)) * HTB)
#define PG8_SB(b, h) ((4 + (b) * 2 + (h)) * HTB)
#define PG8_STAGE(bufoff, gbase, voff) do { _Pragma("unroll") for (int _i = 0; _i < 2; ++_i) \
        __builtin_amdgcn_global_load_lds((const unsigned*)((const char*)(gbase) + (voff)[_i]), (LAS unsigned*)(lds + (bufoff) + ldsw + _i * 8192), 16, 0, 0); } while (0)
#define PG8_LDA(dst, b, h) do { _Pragma("unroll") for (int m = 0; m < 4; ++m) _Pragma("unroll") for (int k = 0; k < 2; ++k) dst[m][k] = *(const LAS bf16x8*)(lds + PG8_SA(b, h) + aoff + m * 2048 + k * 1024); } while (0)
#define PG8_LDB(dst, b, h) do { _Pragma("unroll") for (int n = 0; n < 2; ++n) _Pragma("unroll") for (int k = 0; k < 2; ++k) dst[n][k] = *(const LAS bf16x8*)(lds + PG8_SB(b, h) + boff + n * 2048 + k * 1024); } while (0)
#define PG8_MMA(ai, bj, At, Bt) do { __builtin_amdgcn_s_setprio(1); _Pragma("unroll") for (int m = 0; m < 4; ++m) _Pragma("unroll") for (int n = 0; n < 2; ++n) _Pragma("unroll") for (int k = 0; k < 2; ++k) \
        acc[ai][bj][m][n] = __builtin_amdgcn_mfma_f32_16x16x32_bf16(Bt[n][k], At[m][k], acc[ai][bj][m][n], 0, 0, 0); __builtin_amdgcn_s_setprio(0); } while (0)
#define PG8_WAIT_V(n) asm volatile("s_waitcnt vmcnt(" #n ")" ::: "memory")
#define PG8_WAIT_L(n) asm volatile("s_waitcnt lgkmcnt(" #n ")" ::: "memory")
#define PG8_BAR __builtin_amdgcn_s_barrier()
#define PG8_SCHED __builtin_amdgcn_sched_barrier(0)
    Unit cur, nxt; int ui = 0;
    if (!S.next(0, cur)) return;
    f32x4 acc[2][2][4][2];
#pragma unroll
    for (int a = 0; a < 2; ++a)
#pragma unroll
        for (int b = 0; b < 2; ++b)
#pragma unroll
            for (int m = 0; m < 4; ++m)
#pragma unroll
                for (int n = 0; n < 2; ++n) acc[a][b][m][n] = (f32x4){0.f, 0.f, 0.f, 0.f};
    bf16x8 At[4][2], B0[2][2], B1[2][2];
    const char* cA = (const char*)g.A + (size_t)cur.pm * tstep; const char* cB = (const char*)g.Bt + (size_t)cur.pn * tstep;
    PG8_STAGE(PG8_SB(0, 0), cB, voffB); PG8_STAGE(PG8_SA(0, 0), cA, voffA); PG8_STAGE(PG8_SB(0, 1), cB + hstep, voffB); PG8_STAGE(PG8_SA(0, 1), cA + hstep, voffA);
    if (wr == 1) PG8_BAR;
    PG8_WAIT_V(4); PG8_BAR;
    PG8_STAGE(PG8_SB(1, 0), cB + kstep, voffB); PG8_STAGE(PG8_SA(1, 0), cA + kstep, voffA); PG8_STAGE(PG8_SB(1, 1), cB + hstep + kstep, voffB);
    PG8_WAIT_V(6); PG8_BAR;
    for (;;) {
        const bool has_next = S.next(ui + 1, nxt);
        const char* nA = has_next ? (const char*)g.A + (size_t)nxt.pm * tstep : cA; const char* nB = has_next ? (const char*)g.Bt + (size_t)nxt.pn * tstep : cB;
        for (int t = 0; t < nt; t += 2) {
            const bool last = (t == nt - 2);
            const char* a1 = cA + (size_t)(t + 1) * kstep;
            const char* a2 = last ? nA : cA + (size_t)(t + 2) * kstep; const char* b2 = last ? nB : cB + (size_t)(t + 2) * kstep;
            const char* a3 = a2 + kstep; const char* b3 = b2 + kstep;
            PG8_LDB(B0, 0, 0); PG8_SCHED; PG8_LDA(At, 0, 0); PG8_STAGE(PG8_SA(1, 1), a1 + hstep, voffA);
            PG8_WAIT_L(8); PG8_BAR; PG8_WAIT_L(0); PG8_MMA(0, 0, At, B0); PG8_BAR; PG8_SCHED;
            PG8_LDB(B1, 0, 1); PG8_STAGE(PG8_SB(0, 0), b2, voffB);
            PG8_BAR; PG8_WAIT_L(0); PG8_MMA(0, 1, At, B1); PG8_BAR;
            PG8_LDA(At, 0, 1); PG8_STAGE(PG8_SA(0, 0), a2, voffA);
            PG8_BAR; PG8_WAIT_L(0); PG8_MMA(1, 0, At, B0); PG8_BAR; PG8_SCHED;
            PG8_STAGE(PG8_SB(0, 1), b2 + hstep, voffB);
            PG8_WAIT_V(6); PG8_BAR; PG8_MMA(1, 1, At, B1); PG8_BAR;
            PG8_LDB(B0, 1, 0); PG8_SCHED; PG8_LDA(At, 1, 0); PG8_STAGE(PG8_SA(0, 1), a2 + hstep, voffA);
            PG8_WAIT_L(8); PG8_BAR; PG8_WAIT_L(0); PG8_MMA(0, 0, At, B0); PG8_BAR; PG8_SCHED;
            PG8_LDB(B1, 1, 1); PG8_STAGE(PG8_SB(1, 0), b3, voffB);
            PG8_BAR; PG8_WAIT_L(0); PG8_MMA(0, 1, At, B1); PG8_BAR;
            PG8_LDA(At, 1, 1); PG8_STAGE(PG8_SA(1, 0), a3, voffA);
            PG8_BAR; PG8_WAIT_L(0); PG8_MMA(1, 0, At, B0); PG8_BAR; PG8_SCHED;
            PG8_STAGE(PG8_SB(1, 1), b3 + hstep, voffB);
            PG8_WAIT_V(6); PG8_BAR; PG8_MMA(1, 1, At, B1); PG8_BAR;
        }
        E(acc, cur, ui, wr, wc, fr, fq);
        if (!has_next) break;
#pragma unroll
        for (int a = 0; a < 2; ++a)
#pragma unroll
            for (int b = 0; b < 2; ++b)
#pragma unroll
                for (int m = 0; m < 4; ++m)
#pragma unroll
                    for (int n = 0; n < 2; ++n) acc[a][b][m][n] = (f32x4){0.f, 0.f, 0.f, 0.f};
        cur = nxt; cA = nA; cB = nB; ++ui;
    }
    PG8_WAIT_V(0);
    if (wr == 0) PG8_BAR;
    PG8_BAR;
#undef PG8_SA
#undef PG8_SB
#undef PG8_STAGE
#undef PG8_LDA
#undef PG8_LDB
#undef PG8_MMA
#undef PG8_WAIT_V
#undef PG8_WAIT_L
#undef PG8_BAR
#undef PG8_SCHED
}
}
using pg8::Unit;

constexpr int RT_OFF = 131072;
template <bool SCALE> struct EpiSwiGLU {
    bf16_t* act; const LAS float* rt;
    __device__ __forceinline__ void operator()(const f32x4 (&acc)[2][2][4][2], const Unit& u, int ui, int wr, int wc, int fr, int fq) const {
        const int row0 = u.pm * 256 + wr * 64 + fr, col0 = u.pn * 128 + wc * 32 + 8 * fq; const LAS float* rtu = rt + ui * 256 + wr * 64 + fr;
        float rs[2][4];
#pragma unroll
        for (int ai = 0; ai < 2; ++ai)
#pragma unroll
            for (int m = 0; m < 4; ++m) rs[ai][m] = SCALE ? rtu[ai * 128 + m * 16] : 1.f;
#pragma unroll
        for (int ai = 0; ai < 2; ++ai)
#pragma unroll
            for (int m = 0; m < 4; ++m) {
                const int row = row0 + ai * 128 + m * 16;
                const float r = rs[ai][m];
                float hv[8];
#pragma unroll
                for (int n = 0; n < 2; ++n)
#pragma unroll
                    for (int j = 0; j < 4; ++j) { const float g = acc[ai][0][m][n][j] * r, up = acc[ai][1][m][n][j] * r; hv[4 * n + j] = silu_f(g) * up; }
                u32x4 w = {pk2(hv[0], hv[1]), pk2(hv[2], hv[3]), pk2(hv[4], hv[5]), pk2(hv[6], hv[7])};
                *(u32x4*)(act + (size_t)row * FF + col0) = w;
            }
    }
};
template <int MODE> struct EpiResid {
    const float* residf; const bf16_t* residb; float* outf; bf16_t* outb; float* ss; float scale;
    __device__ __forceinline__ void operator()(const f32x4 (&acc)[2][2][4][2], const Unit& u, int ui, int wr, int wc, int fr, int fq) const {
        const int row0 = u.pm * 256 + wr * 64 + fr, col0 = u.pn * 256 + wc * 32 + 8 * fq;
#pragma unroll
        for (int ai = 0; ai < 2; ++ai) {
            f32x4 rf[MODE == 0 ? 4 : 1][2][2]; u32x4 rb[MODE == 0 ? 1 : 4][2];
#pragma unroll
            for (int m = 0; m < 4; ++m)
#pragma unroll
                for (int bj = 0; bj < 2; ++bj) { const size_t off = (size_t)(row0 + ai * 128 + m * 16) * 1024 + col0 + bj * 128;
                    if constexpr (MODE == 0) { rf[m][bj][0] = *(const f32x4*)(residf + off); rf[m][bj][1] = *(const f32x4*)(residf + off + 4); }
                    else rb[m][bj] = *(const u32x4*)(residb + off); }
#pragma unroll
            for (int m = 0; m < 4; ++m) {
                const int row = row0 + ai * 128 + m * 16; float sq = 0.f;
#pragma unroll
                for (int bj = 0; bj < 2; ++bj) {
                    const size_t off = (size_t)row * 1024 + col0 + bj * 128;
                    f32x4 r0, r1;
                    if constexpr (MODE == 0) { r0 = rf[m][bj][0]; r1 = rf[m][bj][1]; }
                    else { const u32x4 q = rb[m][bj]; r0 = (f32x4){bflo(q[0]), bfhi(q[0]), bflo(q[1]), bfhi(q[1])}; r1 = (f32x4){bflo(q[2]), bfhi(q[2]), bflo(q[3]), bfhi(q[3])}; }
                    const f32x4 v0 = r0 + scale * acc[ai][bj][m][0], v1 = r1 + scale * acc[ai][bj][m][1];
                    if constexpr (MODE == 2) { *(f32x4*)(outf + off) = v0; *(f32x4*)(outf + off + 4) = v1; }
                    else { u32x4 w = {pk2(v0[0], v0[1]), pk2(v0[2], v0[3]), pk2(v1[0], v1[1]), pk2(v1[2], v1[3])}; *(u32x4*)(outb + off) = w;
                        sq += v0[0] * v0[0] + v0[1] * v0[1] + v0[2] * v0[2] + v0[3] * v0[3] + v1[0] * v1[0] + v1[1] * v1[1] + v1[2] * v1[2] + v1[3] * v1[3]; }
                }
                if constexpr (MODE != 2) { if (ss) { sq += __shfl_xor(sq, 16); sq += __shfl_xor(sq, 32); if (fq == 0) unsafeAtomicAdd(ss + row, sq); } }
            }
        }
    }
};
struct EpiInProj {
    bf16_t* Pa; bf16_t* Pb; const LAS float* rt;
    __device__ __forceinline__ void operator()(const f32x4 (&acc)[2][2][4][2], const Unit& u, int ui, int wr, int wc, int fr, int fq) const {
        const int row0 = u.pm * 256 + wr * 64 + fr, col0 = u.pn * 256 + wc * 32 + 8 * fq;
        const bool toA = u.pn < 10; const LAS float* rtu = rt + ui * 256 + wr * 64 + fr;
#pragma unroll
        for (int ai = 0; ai < 2; ++ai)
#pragma unroll
            for (int m = 0; m < 4; ++m) {
                const int row = row0 + ai * 128 + m * 16;
                const float r = rtu[ai * 128 + m * 16];
#pragma unroll
                for (int bj = 0; bj < 2; ++bj) {
                    const f32x4 v0 = acc[ai][bj][m][0] * r, v1 = acc[ai][bj][m][1] * r;
                    u32x4 w = {pk2(v0[0], v0[1]), pk2(v0[2], v0[3]), pk2(v1[0], v1[1]), pk2(v1[2], v1[3])};
                    const int col = col0 + bj * 128;
                    bf16_t* dst = toA ? Pa + (size_t)row * PA_LD + col : Pb + (size_t)row * 1024 + (col - 2560);
                    *(u32x4*)dst = w;
                }
            }
    }
};

__device__ __forceinline__ float wave_sum(float v) {
#pragma unroll
    for (int o = 1; o < 64; o <<= 1) v += __shfl_xor(v, o);
    return v;
}
__device__ __forceinline__ void transpose_item(const float* src, int ldsrc, int K, int k0, int c0, bf16_t* dst, int r0, const float* gain, LAS float* scr, int lane) {
    float v[32];
    const float* sp = src + (size_t)(k0 + (lane >> 5)) * ldsrc + c0 + (lane & 31);
#pragma unroll
    for (int i = 0; i < 32; ++i) v[i] = sp[(size_t)(2 * i) * ldsrc];
    if (gain) {
#pragma unroll
        for (int i = 0; i < 32; ++i) v[i] *= gain[k0 + 2 * i + (lane >> 5)];
    }
#pragma unroll
    for (int i = 0; i < 32; ++i) scr[(2 * i + (lane >> 5)) * 33 + (lane & 31)] = v[i];
    __builtin_amdgcn_wave_barrier();
    const int c = lane & 7;
#pragma unroll
    for (int j = 0; j < 4; ++j) { const int n = (lane >> 3) + 8 * j; const LAS float* sq = scr + (8 * c) * 33 + n;
        u32x4 o = {pk2(sq[0], sq[33]), pk2(sq[66], sq[99]), pk2(sq[132], sq[165]), pk2(sq[198], sq[231])};
        *(u32x4*)(dst + (size_t)(r0 + n) * K + k0 + 8 * c) = o; }
    __builtin_amdgcn_wave_barrier();
}
__device__ __forceinline__ void phase_prep(const Params& p, LAS unsigned char* lds) {
    const int tid = threadIdx.x, nb = gridDim.x, bid = blockIdx.x, wave = tid >> 6, lane = tid & 63;
    unsigned char* ws = p.ws;
    float* ss1 = (float*)(ws + WS_SS1); float* ss2 = (float*)(ws + WS_SS2); float* ss3 = (float*)(ws + WS_SS3);
    for (int i = bid * 512 + tid; i < T; i += nb * 512) { ss2[i] = 0.f; ss3[i] = 0.f; }
    if (bid == 0 && wave == 1) {
        float gq = fabsf(p.in[I_QNORM][lane]), gk = fabsf(p.in[I_KNORM][lane]);
#pragma unroll
        for (int o = 1; o < 64; o <<= 1) { gq = fmaxf(gq, __shfl_xor(gq, o)); gk = fmaxf(gk, __shfl_xor(gk, o)); }
        if (lane == 0) ((float*)(ws + WS_CTR))[32] = fminf(0.18033688f * 64.f * 1.02f * gq * gk, 60.f);
    }
    { bf16_t* wab = (bf16_t*)(ws + WS_WAB); const float* win = p.in[I_WIN]; const float* gn = p.in[I_MIXN];
      for (int idx = bid * 512 + tid; idx < 16 * 1024; idx += nb * 512) { const int n = idx >> 10, k = idx & 1023;
          wab[idx] = n < 8 ? f2bf(win[(size_t)k * 3592 + 2048 + n] * gn[k]) : (bf16_t)0; } }
    { const float* x = p.in[I_X]; bf16_t* xb = (bf16_t*)(ws + WS_X);
      for (int row = bid * 8 + wave; row < T; row += nb * 8) {
          const f32x4* xr = (const f32x4*)(x + (size_t)row * 1024); f32x4 v[4]; float s = 0.f;
#pragma unroll
          for (int j = 0; j < 4; ++j) { v[j] = xr[lane + 64 * j]; s += v[j][0] * v[j][0] + v[j][1] * v[j][1] + v[j][2] * v[j][2] + v[j][3] * v[j][3]; }
          s = wave_sum(s); if (lane == 0) ss1[row] = s;
          const float rn = rsqrtf(s * (1.f / 1024.f) + EPS);
          u32x2* o = (u32x2*)(xb + (size_t)row * 1024);
#pragma unroll
          for (int j = 0; j < 4; ++j) { u32x2 w = {pk2(v[j][0] * rn, v[j][1] * rn), pk2(v[j][2] * rn, v[j][3] * rn)}; o[lane + 64 * j] = w; }
      } }
    LAS float* scr = (LAS float*)(lds + wave * 8448);
    constexpr int N_GU = 88 * 16, N_D = 16 * 44, N_IN = 56 * 16, N_OUT = 16 * 16, N_ALL = 2 * (N_GU + N_D) + N_IN + N_OUT;
    for (int wi = bid * 8 + wave; wi < 2 * N_ALL; wi += nb * 8) {
        int r = wi >> 1; const int hf = (wi & 1) * 32;
        if (r < 2 * N_GU) { const int f = r / N_GU; r -= f * N_GU; const int rt = r >> 4, kt = r & 15, r0 = rt * 64;
            const int pn = r0 >> 8, bj = (r0 >> 7) & 1, rr = r0 & 127;
            const float* src = bj ? p.in[f ? I_F2U : I_F1U] : p.in[f ? I_F2G : I_F1G];
            transpose_item(src, FF, 1024, kt * 64, pn * 128 + rr + hf, (bf16_t*)(ws + (f ? WS_WGU2 : WS_WGU1)), r0 + hf, p.in[f ? I_F2N : I_F1N], scr, lane); continue; }
        r -= 2 * N_GU;
        if (r < 2 * N_D) { const int f = r / N_D; r -= f * N_D; const int rt = r / 44, kt = r % 44;
            transpose_item(p.in[f ? I_F2D : I_F1D], 1024, FF, kt * 64, rt * 64 + hf, (bf16_t*)(ws + (f ? WS_WD2 : WS_WD1)), rt * 64 + hf, nullptr, scr, lane); continue; }
        r -= 2 * N_D;
        if (r < N_IN) { const int rt = r >> 4, kt = r & 15, r0 = rt * 64;
            transpose_item(p.in[I_WIN], 3592, 1024, kt * 64, (r0 < 2048 ? r0 : r0 + 8) + hf, (bf16_t*)(ws + WS_WIN), r0 + hf, p.in[I_MIXN], scr, lane); continue; }
        r -= N_IN;
        { const int rt = r >> 4, kt = r & 15; transpose_item(p.in[I_WOUT], 1024, 1024, kt * 64, rt * 64 + hf, (bf16_t*)(ws + WS_WOUT), rt * 64 + hf, nullptr, scr, lane); }
    }
}

__device__ __forceinline__ void ab_rows(const Params& p) {
    const int tid = threadIdx.x, wave = tid >> 6, lane = tid & 63, fr = lane & 15, fq = lane >> 4;
    const bf16_t* x1b = (const bf16_t*)(p.ws + WS_X); const bf16_t* wab = (const bf16_t*)(p.ws + WS_WAB);
    const float* ss2 = (const float*)(p.ws + WS_SS2); float* ab = (float*)(p.ws + WS_AB);
    for (int wt = blockIdx.x * 8 + wave; wt < T / 16; wt += gridDim.x * 8) {
        const int row0 = wt * 16;
        const bf16_t* arow = x1b + (size_t)(row0 + fr) * 1024 + fq * 8; const bf16_t* brow = wab + (size_t)fr * 1024 + fq * 8;
        f32x4 acc = {0.f, 0.f, 0.f, 0.f};
#pragma unroll 8
        for (int ks = 0; ks < 32; ++ks) { const bf16x8 a = *(const bf16x8*)(arow + ks * 32), b = *(const bf16x8*)(brow + ks * 32); acc = MFMA16(a, b, acc); }
        if (fr < 8) {
#pragma unroll
            for (int j = 0; j < 4; ++j) { const int row = row0 + 4 * fq + j; ab[(size_t)row * 8 + fr] = acc[j] * rsqrtf(ss2[row] * (1.f / 1024.f) + EPS); }
        }
    }
}

constexpr int G1_HALF = 78080;
__device__ __forceinline__ void g1_item(const Params& p, LAS unsigned char* lds, int item) {
    int tid = threadIdx.x; asm volatile("" : "+v"(tid));
    const int hh = tid >> 8, tl = tid & 255, lane = tid & 63, wv4 = tl >> 6, fr = lane & 15, fq = lane >> 4;
    const int hp = item & 1, n = (item >> 1) & 63, b = item >> 7, h = 2 * hp + hh;
    const int chh = (b * 4 + h) * 64 + n, t0 = b * SEQ + n * 64;
    LAS unsigned char* base = lds + hh * G1_HALF;
    LAS bf16_t* Kb = (LAS bf16_t*)base; LAS bf16_t* Qb = (LAS bf16_t*)(base + 17408); LAS bf16_t* Vb = (LAS bf16_t*)(base + 34816);
    LAS float* Lm = (LAS float*)(base + 52224); LAS bf16_t* Ais = (LAS bf16_t*)(base + 68608);
    LAS float* gc = (LAS float*)(base + 76800); LAS float* beta = gc + 64; LAS float* eg = gc + 128;
    const bf16_t* Pa = (const bf16_t*)(p.ws + WS_R1);
    {
        const int dg = tl & 15, tg = tl >> 4, d0 = 8 * dg;
#pragma unroll
        for (int sec = 0; sec < 3; ++sec) {
            const int col = sec * 512 + h * 128 + d0;
            float w[4][8];
#pragma unroll
            for (int kk = 0; kk < 4; ++kk) { const f32x4 wa = *(const f32x4*)(p.in[I_CONV] + kk * 1536 + col), wb = *(const f32x4*)(p.in[I_CONV] + kk * 1536 + col + 4);
#pragma unroll
                for (int e = 0; e < 4; ++e) { w[kk][e] = wa[e]; w[kk][4 + e] = wb[e]; } }
            u32x4 xr[7];
#pragma unroll
            for (int rr = 0; rr < 7; ++rr) { const int tok = n * 64 + 4 * tg - 3 + rr;
                if (tok >= 0) xr[rr] = *(const u32x4*)(Pa + (size_t)(b * SEQ + tok) * PA_LD + col); else xr[rr] = (u32x4){0u, 0u, 0u, 0u}; }
            LAS bf16_t* dstb = sec == 0 ? Qb : (sec == 1 ? Kb : Vb);
#pragma unroll
            for (int ti = 0; ti < 4; ++ti) {
                float y[8]; float ssq = 0.f;
#pragma unroll
                for (int e = 0; e < 8; ++e) { float a = 0.f;
#pragma unroll
                    for (int kk = 0; kk < 4; ++kk) { const unsigned wd = xr[ti + kk][e >> 1]; a += w[kk][e] * ((e & 1) ? bfhi(wd) : bflo(wd)); }
                    y[e] = silu_f(a); ssq += y[e] * y[e]; }
                if (sec < 2) {
                    ssq += __shfl_xor(ssq, 1); ssq += __shfl_xor(ssq, 2); ssq += __shfl_xor(ssq, 4); ssq += __shfl_xor(ssq, 8);
                    const float rn = rsqrtf(ssq + EPS) * (sec == 0 ? 0.08838834764831845f : 1.f);
#pragma unroll
                    for (int e = 0; e < 8; ++e) y[e] *= rn;
                }
                u32x4 o = {pk2(y[0], y[1]), pk2(y[2], y[3]), pk2(y[4], y[5]), pk2(y[6], y[7])};
                *(LAS u32x4*)(dstb + (4 * tg + ti) * 136 + d0) = o;
            }
        }
    }
    if (tl < 64) {
        const int i = tl; const float* ab = (const float*)(p.ws + WS_AB);
        const float a = ab[(size_t)(t0 + i) * 8 + h], bb = ab[(size_t)(t0 + i) * 8 + 4 + h];
        const float A = expf(p.in[I_ALOG][h]); const float xx = a + p.in[I_DTB][h];
        const float sp = xx > 20.f ? xx : log1pf(expf(xx));
        float g = -A * sp;
#pragma unroll
        for (int off = 1; off < 64; off <<= 1) { const float t = __shfl_up(g, off); if (lane >= off) g += t; }
        const float bt = 1.f / (1.f + expf(-bb)), egi = expf(g);
        gc[i] = g; beta[i] = bt; eg[i] = egi; eg[64 + i] = bt * egi; eg[128 + i] = expf(__shfl(g, 63) - g);
        if (i == 63) ((float*)(p.ws + WS_GLAST))[chh] = expf(g);
    }
    __syncthreads();
    {
        const int mt = wv4;
#pragma unroll
        for (int nt = 0; nt < 4; ++nt) {
            f32x4 aK = {0.f, 0.f, 0.f, 0.f}, aQ = {0.f, 0.f, 0.f, 0.f};
#pragma unroll
            for (int ks = 0; ks < 4; ++ks) {
                const bf16x8 bk = *(const LAS bf16x8*)(Kb + (16 * nt + fr) * 136 + 32 * ks + 8 * fq);
                const bf16x8 ak = *(const LAS bf16x8*)(Kb + (16 * mt + fr) * 136 + 32 * ks + 8 * fq);
                const bf16x8 aq = *(const LAS bf16x8*)(Qb + (16 * mt + fr) * 136 + 32 * ks + 8 * fq);
                aK = MFMA16(ak, bk, aK); aQ = MFMA16(aq, bk, aQ);
            }
            const int j = 16 * nt + fr; const float gj = gc[j];
#pragma unroll
            for (int jj = 0; jj < 4; ++jj) { const int i = 16 * mt + 4 * fq + jj;
                const float dec = (i >= j) ? expf(gc[i] - gj) : 0.f;
                Lm[i * 64 + j] = (i > j) ? beta[i] * aK[jj] * dec : 0.f;
                Ais[i * 64 + 32 * (j >> 5) + pos32(j & 31)] = f2bf(aQ[jj] * dec); }
        }
    }
    {
        const int i = tl >> 2, g32 = tl & 3; const float sc = eg[i];
        float a[32];
#pragma unroll
        for (int c4 = 0; c4 < 4; ++c4) { const u32x4 v = *(const LAS u32x4*)(Qb + i * 136 + 32 * g32 + 8 * c4);
#pragma unroll
            for (int e = 0; e < 4; ++e) { a[8 * c4 + 2 * e] = bflo(v[e]) * sc; a[8 * c4 + 2 * e + 1] = bfhi(v[e]) * sc; } }
        bf16_t* dq = (bf16_t*)(p.ws + WS_QD) + (size_t)chh * 8192 + i * 128 + 32 * g32;
#pragma unroll
        for (int c4 = 0; c4 < 4; ++c4) { u32x4 o;
#pragma unroll
            for (int e = 0; e < 4; ++e) o[e] = pk2(a[act32(8 * c4 + 2 * e)], a[act32(8 * c4 + 2 * e + 1)]);
            *(u32x4*)(dq + 8 * c4) = o; }
    }
    {
        const int d = tl >> 1, tgp = tl & 1; const float gl = gc[63];
        bf16_t* dk = (bf16_t*)(p.ws + WS_KD) + (size_t)chh * 8192 + d * 64 + 32 * tgp;
#pragma unroll
        for (int c4 = 0; c4 < 4; ++c4) { u32x4 o;
#pragma unroll
            for (int e = 0; e < 4; ++e) { const int i0 = 32 * tgp + act32(8 * c4 + 2 * e), i1 = 32 * tgp + act32(8 * c4 + 2 * e + 1);
                o[e] = pk2(bf2f(Kb[i0 * 136 + d]) * expf(gl - gc[i0]), bf2f(Kb[i1 * 136 + d]) * expf(gl - gc[i1])); }
            *(u32x4*)(dk + 8 * c4) = o; }
    }
    __syncthreads();
#pragma unroll
    for (int ii = 0; ii < 2; ++ii) { const int id = tl + 256 * ii; *(u32x4*)((bf16_t*)(p.ws + WS_AI) + (size_t)chh * 4096 + id * 8) = *(const LAS u32x4*)(Ais + id * 8); }
    {
        const int c = tl; f32x2 xp[32];
        const LAS bf16_t* rsrc = c < 128 ? Vb + c : Kb + (c - 128);
        const LAS float* rsc = c < 128 ? beta : eg + 64;
#pragma unroll
        for (int q = 0; q < 32; ++q) xp[q] = (f32x2){0.f, 0.f};
#pragma unroll
        for (int i = 0; i < 64; ++i) {
            f32x2 acc = {rsc[i] * bf2f(rsrc[i * 136]), 0.f};
#pragma unroll
            for (int j4 = 0; j4 < (i + 3) / 4; ++j4) { const f32x4 l = *(const LAS f32x4*)(Lm + i * 64 + 4 * j4);
                acc -= (f32x2){l[0], l[1]} * xp[2 * j4]; if (4 * j4 + 2 < i) acc -= (f32x2){l[2], l[3]} * xp[2 * j4 + 1]; }
            const float xi = acc[0] + acc[1];
            if (i & 1) xp[i >> 1][1] = xi; else xp[i >> 1][0] = xi;
            if ((i & 3) == 3) __builtin_amdgcn_sched_barrier(0);
        }
#define x(i_) xp[(i_) >> 1][(i_) & 1]
        __syncthreads();
        LAS bf16_t* stg = (LAS bf16_t*)base;
        if (c < 128) {
            LAS bf16_t* us = stg + 8192 + (c >> 4) * 1024 + (c & 15) * 4;
#pragma unroll
            for (int mt = 0; mt < 4; ++mt)
#pragma unroll
                for (int q = 0; q < 4; ++q) { const int i = 16 * mt + 4 * q; u32x2 o = {pk2(x(i), x(i + 1)), pk2(x(i + 2), x(i + 3))}; *(LAS u32x2*)(us + mt * 256 + q * 64) = o; }
        } else {
            const int kd = c - 128; LAS bf16_t* wn = stg + 32 * (kd >> 5) + pos32(kd & 31);
#pragma unroll
            for (int i = 0; i < 64; ++i) wn[i * 128] = f2bf(-x(i));
        }
    }
#undef x
    __syncthreads();
    {
        LAS bf16_t* stg = (LAS bf16_t*)base;
        bf16_t* gw = (bf16_t*)(p.ws + WS_WN) + (size_t)chh * 8192; bf16_t* gu = (bf16_t*)(p.ws + WS_US) + (size_t)chh * 8192;
#pragma unroll
        for (int ii = 0; ii < 4; ++ii) { const int id = tl + 256 * ii;
            *(u32x4*)(gw + id * 8) = *(const LAS u32x4*)(stg + id * 8);
            *(u32x4*)(gu + id * 8) = *(const LAS u32x4*)(stg + 8192 + id * 8); }
    }
    __syncthreads();
}

__device__ __forceinline__ void moba_prep_item(const Params& p, LAS unsigned char* lds, int item, bool dry = false) {
    const int tid = threadIdx.x;
    const int h = item & 7, blk = (item >> 3) & 15, b = item >> 7, t0 = b * SEQ + blk * 256;
    LAS float* scr = (LAS float*)lds; LAS bf16_t* vt = (LAS bf16_t*)(lds + 66560); LAS float* part = (LAS float*)(lds + 100352);
    const bf16_t* Pa = (const bf16_t*)(p.ws + WS_R1); bf16_t* O = (bf16_t*)(p.ws + WS_O);
    bf16_t* kn = (bf16_t*)p.out; bf16_t* Vt = (bf16_t*)p.out + (size_t)T * 512;
    {
        const int key = tid >> 1, half = tid & 1;
        const bf16_t* src = O + (size_t)(t0 + key) * 1024 + 512 + h * 64 + half * 32;
        const int kp = 32 * (key >> 5) + pos32(key & 31);
#pragma unroll
        for (int c4 = 0; c4 < 4; ++c4) { const u32x4 v = *(const u32x4*)(src + 8 * c4);
#pragma unroll
            for (int e = 0; e < 4; ++e) { vt[(half * 32 + 8 * c4 + 2 * e) * 264 + kp] = (bf16_t)(v[e] & 0xffffu); vt[(half * 32 + 8 * c4 + 2 * e + 1) * 264 + kp] = (bf16_t)(v[e] >> 16); } }
    }
    __syncthreads();
    {
        const int role = tid >> 8, tok = tid & 255;
        const bf16_t* src = role == 0 ? Pa + (size_t)(t0 + tok) * PA_LD + 2048 + h * 64 : O + (size_t)(t0 + tok) * 1024 + h * 64;
        const float* gain = p.in[role == 0 ? I_QNORM : I_KNORM];
        float v[64]; float ssq = 0.f;
#pragma unroll
        for (int c8 = 0; c8 < 8; ++c8) { const u32x4 w = *(const u32x4*)(src + 8 * c8);
#pragma unroll
            for (int e = 0; e < 4; ++e) { v[8 * c8 + 2 * e] = bflo(w[e]); v[8 * c8 + 2 * e + 1] = bfhi(w[e]); } }
#pragma unroll
        for (int i = 0; i < 64; ++i) ssq += v[i] * v[i];
        const float rn = rsqrtf(ssq * (1.f / 64.f) + EPS);
#pragma unroll
        for (int i = 0; i < 64; ++i) v[i] = v[i] * rn * gain[i];
        const float posf = (float)(blk * 256 + tok);
        const float invf[8] = {1.0f, 0.1939227432012558f, 0.03760603070259094f, 0.007292664609849453f, 0.0014142135623842478f, 0.00027424818836152554f, 5.318296098266728e-05f, 1.0313386155758053e-05f};
#pragma unroll
        for (int i = 0; i < 8; ++i) {
            const float ang = posf * invf[i];
            double rev = (double)ang * 0.15915494309189535; rev -= rint(rev);
            const float sn = __builtin_amdgcn_sinf((float)rev), cs = __builtin_amdgcn_cosf((float)rev);
            const float x1 = v[i], x2 = v[i + 8];
            v[i] = x1 * cs - x2 * sn; v[i + 8] = x2 * cs + x1 * sn;
        }
        bf16_t* dst = role == 0 ? (dry ? (bf16_t*)(p.ws + WS_END) + (size_t)tok * 1024 : O + (size_t)(t0 + tok) * 1024) + 512 + h * 64 : kn + (size_t)(t0 + tok) * 512 + h * 64;
#pragma unroll
        for (int c8 = 0; c8 < 8; ++c8) { u32x4 w = {pk2(v[8 * c8], v[8 * c8 + 1]), pk2(v[8 * c8 + 2], v[8 * c8 + 3]), pk2(v[8 * c8 + 4], v[8 * c8 + 5]), pk2(v[8 * c8 + 6], v[8 * c8 + 7])};
            *(u32x4*)(dst + 8 * c8) = w; }
        if (role == 1) {
#pragma unroll
            for (int i = 0; i < 64; ++i) scr[tok * 65 + i] = v[i];
        }
    }
    __syncthreads();
    if (tid < 256) { const int d = tid & 63, pt = tid >> 6; float s = 0.f;
        for (int r = 0; r < 64; ++r) s += scr[(64 * pt + r) * 65 + d];
        part[pt * 64 + d] = s; }
#pragma unroll
    for (int ii = 0; ii < 4; ++ii) { const int id = tid + 512 * ii, d = id >> 5, cc = id & 31;
        *(u32x4*)(Vt + ((size_t)((b * 8 + h) * 16 + blk) * 64 + d) * 256 + cc * 8) = *(const LAS u32x4*)(vt + d * 264 + cc * 8); }
    __syncthreads();
    if (tid < 64) ((float*)(p.ws + WS_KMEAN))[((size_t)((b * 8 + h) * 16) + blk) * 64 + tid] = (part[tid] + part[64 + tid] + part[128 + tid] + part[192 + tid]) * (1.f / 256.f);
    __syncthreads();
}

__device__ __forceinline__ float row16_sum(float v) {
    v += __builtin_bit_cast(float, __builtin_amdgcn_update_dpp(0, __builtin_bit_cast(int, v), 0xB1, 0xF, 0xF, true));
    v += __builtin_bit_cast(float, __builtin_amdgcn_update_dpp(0, __builtin_bit_cast(int, v), 0x4E, 0xF, 0xF, true));
    v += __builtin_bit_cast(float, __builtin_amdgcn_update_dpp(0, __builtin_bit_cast(int, v), 0x141, 0xF, 0xF, true));
    v += __builtin_bit_cast(float, __builtin_amdgcn_update_dpp(0, __builtin_bit_cast(int, v), 0x140, 0xF, 0xF, true));
    return v;
}
template <int DRY>
__device__ __forceinline__ void gdn_scan(const Params& p, LAS unsigned char* lds, int bh) {
    const int tid = threadIdx.x, wv = __builtin_amdgcn_readfirstlane(tid >> 6), lane = tid & 63, fr = lane & 15, fq = lane >> 4;
    const int b = bh >> 2, h = bh & 3;
    const bool cw = wv < 4; const int w4 = wv & 3, tid2 = tid & 255;
    constexpr int W_OFF = 0, Q_OFF = 16384, K_OFF = 32768, A_OFF = 49152, BUF = 57344, OT_OFF = 2 * BUF, RED_OFF = OT_OFF + 2 * 16384;
    LAS float* red = (LAS float*)(lds + RED_OFF);
    const bf16_t* Wn = (const bf16_t*)(p.ws + WS_WN); const bf16_t* Qd = (const bf16_t*)(p.ws + WS_QD); const bf16_t* Kd = (const bf16_t*)(p.ws + WS_KD);
    const bf16_t* Ai = (const bf16_t*)(p.ws + WS_AI); const bf16_t* Us = (const bf16_t*)(p.ws + WS_US); const float* glast = (const float*)(p.ws + WS_GLAST);
    const bf16_t* Pa = (const bf16_t*)(p.ws + WS_R1); bf16_t* O = (bf16_t*)(p.ws + WS_O);
    f32x4 S[8][2];
#pragma unroll
    for (int i = 0; i < 8; ++i) { S[i][0] = (f32x4){0.f, 0.f, 0.f, 0.f}; S[i][1] = (f32x4){0.f, 0.f, 0.f, 0.f}; }
    const int fcc = tid2 & 15;
    LAS float* gainl = (LAS float*)(lds + RED_OFF + 2048);
    if (tid < 128) gainl[tid] = p.in[I_ONORM][tid];
    u32x2 ru[8]; float gl_next = 0.f;
#pragma unroll
    for (int k = 0; k < 8; ++k) ru[k] = (u32x2){0u, 0u};
    const bf16_t* rub = cw ? Us + ((size_t)bh * 64 * 8 + 2 * w4) * 1024 + lane * 4 : Pa + ((size_t)b * SEQ + (tid2 >> 4)) * PA_LD + 1536 + h * 128 + 8 * fcc;
    const size_t ru_step = cw ? (size_t)8192 : (size_t)64 * PA_LD;
    const int ru_a = cw ? 256 : 16 * PA_LD, ru_b = cw ? 1024 : 4;
#define SCAN_GLOAD(nn, zn, par) do { const size_t chh = (size_t)bh * 64 + ((DRY & 4) ? 0 : (nn)); LAS unsigned char* db = lds + ((par) & 1) * BUF + wv * 1024; \
        int lq = lane; asm volatile("" : "+v"(lq));            \
        _Pragma("unroll") for (int i = 0; i < 2; ++i) { \
            const int r16 = 4 * (wv + 8 * i) + (lq >> 4), c16 = (lq & 15) ^ (r16 & 15); const unsigned gw = (unsigned)(r16 * 128 + c16 * 8); \
            const int r8 = 8 * (wv + 8 * i) + (lq >> 3), c8 = (lq & 7) ^ ((r8 >> 1) & 7); const unsigned gk = (unsigned)(r8 * 64 + c8 * 8); \
            __builtin_amdgcn_global_load_lds((const unsigned*)(Wn + chh * 8192 + gw), (LAS unsigned*)(db + W_OFF + i * 8192), 16, 0, 0); \
            __builtin_amdgcn_global_load_lds((const unsigned*)(Qd + chh * 8192 + gw), (LAS unsigned*)(db + Q_OFF + i * 8192), 16, 0, 0); \
            __builtin_amdgcn_global_load_lds((const unsigned*)(Kd + chh * 8192 + gk), (LAS unsigned*)(db + K_OFF + i * 8192), 16, 0, 0); } \
        { const int r8 = 8 * wv + (lq >> 3), c8 = (lq & 7) ^ ((r8 >> 1) & 7); \
          __builtin_amdgcn_global_load_lds((const unsigned*)(Ai + chh * 4096 + (unsigned)(r8 * 64 + c8 * 8)), (LAS unsigned*)(db + A_OFF), 16, 0, 0); } \
        { const bf16_t* rp = rub + (size_t)(cw ? ((DRY & 4) ? 0 : (nn)) : (zn)) * ru_step; \
          _Pragma("unroll") for (int k = 0; k < 8; ++k) ru[k] = *(const u32x2*)(rp + (k >> 1) * ru_a + (k & 1) * ru_b); } \
        if (cw) gl_next = glast[chh]; } while (0)
#define SCAN_STAGE(nn) do { \
        if (cw) { _Pragma("unroll") for (int mt = 0; mt < 4; ++mt) _Pragma("unroll") for (int ct = 0; ct < 2; ++ct) vn[mt][ct] = (f32x4){bflo(ru[2 * mt + ct][0]), bfhi(ru[2 * mt + ct][0]), bflo(ru[2 * mt + ct][1]), bfhi(ru[2 * mt + ct][1])}; gl = gl_next; } } while (0)
#define SCAN_FINAL(nn) do { const int tq = b * SEQ + (nn) * 64; const LAS float* rd = red + ((nn) & 1) * 256; const LAS unsigned char* ot = lds + OT_OFF + ((nn) & 1) * 16384; \
        _Pragma("unroll") for (int ii = 0; ii < 4; ++ii) { const int row = (tid2 >> 4) + 16 * ii; \
            const float tot = (rd[row] + rd[64 + row]) + (rd[128 + row] + rd[192 + row]); const float rstd = rsqrtf(tot * (1.f / 128.f) + EPS); \
            const u32x4 ov = *(const LAS u32x4*)(ot + row * 256 + ((fcc ^ (2 * ((row >> 2) & 3))) * 16)); const u32x4 zz = {ru[2 * ii][0], ru[2 * ii][1], ru[2 * ii + 1][0], ru[2 * ii + 1][1]}; u32x4 res; \
            const f32x4 g0 = *(const LAS f32x4*)(gainl + 8 * fcc), g1 = *(const LAS f32x4*)(gainl + 8 * fcc + 4); const float fgain[8] = {g0[0], g0[1], g0[2], g0[3], g1[0], g1[1], g1[2], g1[3]}; \
            _Pragma("unroll") for (int e = 0; e < 4; ++e) res[e] = pk2(bflo(ov[e]) * rstd * fgain[2 * e] * silu_f(bflo(zz[e])), bfhi(ov[e]) * rstd * fgain[2 * e + 1] * silu_f(bfhi(zz[e]))); \
            if ((DRY & 1) == 0) *(u32x4*)(O + (size_t)(tq + row) * 1024 + h * 128 + 8 * fcc) = res; else if (res[0] == 0x12345u) O[0] = 1; } } while (0)
    SCAN_GLOAD(0, 0, 0);
    f32x4 vn[4][2]; float gl = 0.f;
    SCAN_STAGE(0);
    for (int n = 0; n < 64; ++n) {
        LAS unsigned char* buf = lds + (n & 1) * BUF;
        asm volatile("s_waitcnt vmcnt(0)" ::: "memory");
        asm volatile("s_waitcnt lgkmcnt(0)" ::: "memory");
        __builtin_amdgcn_s_barrier();
        asm volatile("" ::: "memory");
        if (!cw) SCAN_FINAL(n > 0 ? n - 1 : 0);
        SCAN_GLOAD(n + 1 < 64 ? n + 1 : 63, n, n + 1);
        __builtin_amdgcn_sched_barrier(0);
        if (cw) {
            bf16x8 Sb[4][2];
#pragma unroll
            for (int ks = 0; ks < 4; ++ks) { Sb[ks][0] = pack8(S[2 * ks][0], S[2 * ks + 1][0]); Sb[ks][1] = pack8(S[2 * ks][1], S[2 * ks + 1][1]); }
#pragma unroll
            for (int mt = 0; mt < 4; ++mt)
#pragma unroll
                for (int ks = 0; ks < 4; ++ks) { const bf16x8 a = *(const LAS bf16x8*)(buf + W_OFF + (16 * mt + fr) * 256 + (((4 * ks + fq) ^ fr) * 16));
                    vn[mt][0] = MFMA16(a, Sb[ks][0], vn[mt][0]); vn[mt][1] = MFMA16(a, Sb[ks][1], vn[mt][1]); }
            __builtin_amdgcn_sched_barrier(0);
            bf16x8 vb[2][2];
#pragma unroll
            for (int ct = 0; ct < 2; ++ct) { vb[0][ct] = pack8(vn[0][ct], vn[1][ct]); vb[1][ct] = pack8(vn[2][ct], vn[3][ct]); }
#pragma unroll
            for (int mt = 0; mt < 4; ++mt) { vn[mt][0] = (f32x4){0.f, 0.f, 0.f, 0.f}; vn[mt][1] = (f32x4){0.f, 0.f, 0.f, 0.f};
#pragma unroll
                for (int ks = 0; ks < 4; ++ks) { const bf16x8 a = *(const LAS bf16x8*)(buf + Q_OFF + (16 * mt + fr) * 256 + (((4 * ks + fq) ^ fr) * 16));
                    vn[mt][0] = MFMA16(a, Sb[ks][0], vn[mt][0]); vn[mt][1] = MFMA16(a, Sb[ks][1], vn[mt][1]); }
#pragma unroll
                for (int ks = 0; ks < 2; ++ks) { const bf16x8 a = *(const LAS bf16x8*)(buf + A_OFF + (16 * mt + fr) * 128 + (((4 * ks + fq) ^ (fr >> 1)) * 16));
                    vn[mt][0] = MFMA16(a, vb[ks][0], vn[mt][0]); vn[mt][1] = MFMA16(a, vb[ks][1], vn[mt][1]); } }
            __builtin_amdgcn_sched_barrier(0);
            LAS bf16_t* ot = (LAS bf16_t*)(lds + OT_OFF + (n & 1) * 16384);
#pragma unroll
            for (int mt = 0; mt < 4; ++mt) {
                f32x4 sq = vn[mt][0] * vn[mt][0] + vn[mt][1] * vn[mt][1];
#pragma unroll
                for (int j = 0; j < 4; ++j) { sq[j] = row16_sum(sq[j]);
                    const int row = 16 * mt + 4 * fq + j;
                    ot[row * 128 + ((32 * w4 + fr) ^ (16 * fq))] = f2bf(vn[mt][0][j]);
                    ot[row * 128 + ((32 * w4 + 16 + fr) ^ (16 * fq))] = f2bf(vn[mt][1][j]); }
                if (fr == 0) *(LAS f32x4*)(red + (n & 1) * 256 + w4 * 64 + 16 * mt + 4 * fq) = sq;
            }
                    __builtin_amdgcn_sched_barrier(0);
#pragma unroll
            for (int m8 = 0; m8 < 8; ++m8) { S[m8][0] = S[m8][0] * gl; S[m8][1] = S[m8][1] * gl;
#pragma unroll
                for (int ks = 0; ks < 2; ++ks) { const bf16x8 a = *(const LAS bf16x8*)(buf + K_OFF + (16 * m8 + fr) * 128 + (((4 * ks + fq) ^ (fr >> 1)) * 16));
                    S[m8][0] = MFMA16(a, vb[ks][0], S[m8][0]); S[m8][1] = MFMA16(a, vb[ks][1], S[m8][1]); } }
        }
        SCAN_STAGE(n + 1);
    }
    asm volatile("s_waitcnt vmcnt(0)" ::: "memory");
    __syncthreads();
    if (!cw) SCAN_FINAL(63);
#undef SCAN_FINAL
#undef SCAN_STAGE
#undef SCAN_GLOAD
    __syncthreads();
}

__device__ __forceinline__ void moba_attn_item(const Params& p, LAS unsigned char* lds, int item, bool dry = false) {
    const int tid = threadIdx.x, wv = tid >> 6, lane = tid & 63, fr = lane & 15, fq = lane >> 4;
    const int blk = 15 - (item >> 6), bh = item & 63, b = bh >> 3, h = bh & 7, t0 = b * SEQ + blk * 256;
    constexpr int KT_B = 16384, BUF = 32768;
    LAS float* kml = (LAS float*)(lds + 98304); LAS float* gts = (LAS float*)(lds + 102144); LAS unsigned* sel = (LAS unsigned*)(lds + 118528);
    bf16_t* O = (bf16_t*)(p.ws + WS_O); const bf16_t* kn = (const bf16_t*)p.out; const bf16_t* Vt = (const bf16_t*)p.out + (size_t)T * 512;
    const float* kmean = (const float*)(p.ws + WS_KMEAN) + (size_t)((b * 8 + h) * 16) * 64;
    unsigned kofs[2], vofs[2];
#pragma unroll
    for (int i = 0; i < 2; ++i) { const int pc = wv + 8 * i; const int rk = 8 * pc + (lane >> 3), ck = (lane & 7) ^ ((rk >> 1) & 7); kofs[i] = (unsigned)(rk * 512 + ck * 8);
        const int rv = 4 * pc + (lane >> 4), cv = (lane & 15) ^ (rv & 15); vofs[i] = (unsigned)(rv * 256 + cv * 8); }
    const bf16_t* knh = kn + (size_t)b * SEQ * 512 + h * 64; const bf16_t* vth = Vt + (size_t)((b * 8 + h) * 16) * 16384;
#define ATT_DMA(tix_, par_) do { const int nb_ = (tix_) >> 1, hf_ = (tix_) & 1; LAS unsigned char* db = lds + (par_) * BUF + wv * 1024; \
        _Pragma("unroll") for (int i = 0; i < 2; ++i) { \
            __builtin_amdgcn_global_load_lds((const unsigned*)(knh + (size_t)(nb_ * 256 + hf_ * 128) * 512 + kofs[i]), (LAS unsigned*)(db + i * 8192), 16, 0, 0); \
            __builtin_amdgcn_global_load_lds((const unsigned*)(vth + (size_t)nb_ * 16384 + hf_ * 128 + vofs[i]), (LAS unsigned*)(db + KT_B + i * 8192), 16, 0, 0); } } while (0)
    const int ntiles = 2 * blk + 2;
    ATT_DMA(0, 0); ATT_DMA(1, 1);
    bf16x8 qf[2][2];
#pragma unroll
    for (int nt = 0; nt < 2; ++nt)
#pragma unroll
        for (int ks = 0; ks < 2; ++ks) qf[nt][ks] = *(const bf16x8*)(O + (size_t)(t0 + 32 * wv + 16 * nt + fr) * 1024 + 512 + h * 64 + 32 * ks + 8 * fq);
    if (blk > 3) {
        for (int idx = tid; idx < blk * 64; idx += 512) kml[idx] = kmean[idx];
        __syncthreads();
        {
            const int qi = tid & 255, part = tid >> 8; const bf16_t* src = O + (size_t)(t0 + qi) * 1024 + 512 + h * 64;
            u32x4 qp[8];
#pragma unroll
            for (int c8 = 0; c8 < 8; ++c8) qp[c8] = *(const u32x4*)(src + 8 * c8);
            for (int nb = part; nb < blk; nb += 2) { float s = 0.f;
#pragma unroll
                for (int c8 = 0; c8 < 8; ++c8) { const f32x4 ka = *(const LAS f32x4*)(kml + nb * 64 + 8 * c8), kb = *(const LAS f32x4*)(kml + nb * 64 + 8 * c8 + 4);
                    s += bflo(qp[c8][0]) * ka[0] + bfhi(qp[c8][0]) * ka[1] + bflo(qp[c8][1]) * ka[2] + bfhi(qp[c8][1]) * ka[3]
                       + bflo(qp[c8][2]) * kb[0] + bfhi(qp[c8][2]) * kb[1] + bflo(qp[c8][3]) * kb[2] + bfhi(qp[c8][3]) * kb[3]; }
                gts[qi * 16 + nb] = s; }
        }
        __syncthreads();
        if (tid < 256) {
            float v1 = -INFINITY, v2 = -INFINITY, v3 = -INFINITY; int i1 = 0, i2 = 0, i3 = 0;
            for (int nb = 0; nb < blk; ++nb) { const float g = gts[tid * 16 + nb];
                if (g > v1) { v3 = v2; i3 = i2; v2 = v1; i2 = i1; v1 = g; i1 = nb; }
                else if (g > v2) { v3 = v2; i3 = i2; v2 = g; i2 = nb; }
                else if (g > v3) { v3 = g; i3 = nb; } }
            sel[tid] = (1u << i1) | (1u << i2) | (1u << i3);
        }
    } else { if (tid < 256) sel[tid] = (1u << blk) - 1u; }
    __syncthreads();
    unsigned selm[2]; selm[0] = sel[32 * wv + fr]; selm[1] = sel[32 * wv + 16 + fr];
    float lrun[2] = {0.f, 0.f};
    const float mref = ((const float*)(p.ws + WS_CTR))[32];
    f32x4 oacc[4][2];
#pragma unroll
    for (int dt = 0; dt < 4; ++dt) { oacc[dt][0] = (f32x4){0.f, 0.f, 0.f, 0.f}; oacc[dt][1] = (f32x4){0.f, 0.f, 0.f, 0.f}; }
    {
        constexpr float SC = 0.18033688011112042f;
#pragma unroll
        for (int nt = 0; nt < 2; ++nt)
#pragma unroll
            for (int ks = 0; ks < 2; ++ks) { const u32x4 w = __builtin_bit_cast(u32x4, qf[nt][ks]); u32x4 o;
                o[0] = pk2(bflo(w[0]) * SC, bfhi(w[0]) * SC); o[1] = pk2(bflo(w[1]) * SC, bfhi(w[1]) * SC);
                o[2] = pk2(bflo(w[2]) * SC, bfhi(w[2]) * SC); o[3] = pk2(bflo(w[3]) * SC, bfhi(w[3]) * SC);
                qf[nt][ks] = __builtin_bit_cast(bf16x8, o); }
    }
    int bcur = 0;
    for (int tix = 0; tix < ntiles; ++tix) {
        LAS unsigned char* buf = lds + bcur * BUF;
        asm volatile("s_waitcnt vmcnt(4)" ::: "memory");
        __builtin_amdgcn_s_barrier();
        asm volatile("" ::: "memory");
        { const int nx = tix + 2 < ntiles ? tix + 2 : ntiles - 1; const int bn = bcur == 0 ? 2 : bcur - 1;
          ATT_DMA(nx, bn); }
        const int nb = tix >> 1, half = tix & 1; const bool own = (nb == blk);
        bool active;
        if (own) active = (128 * half <= 32 * wv + 31);
        else active = __any((int)(((selm[0] | selm[1]) >> nb) & 1u)) != 0;
        if (active) {
            f32x4 s[8][2];
            float mn[2];
#pragma unroll
            for (int nt = 0; nt < 2; ++nt) mn[nt] = (own || (((selm[nt] >> nb) & 1u) != 0u)) ? -mref : -INFINITY;
#pragma unroll
            for (int kt = 0; kt < 8; ++kt) {
                const bf16x8 k0 = *(const LAS bf16x8*)(buf + (16 * kt + fr) * 128 + ((fq ^ (fr >> 1)) * 16));
                const bf16x8 k1 = *(const LAS bf16x8*)(buf + (16 * kt + fr) * 128 + (((4 + fq) ^ (fr >> 1)) * 16));
#pragma unroll
                for (int nt = 0; nt < 2; ++nt) { f32x4 a = {mn[nt], mn[nt], mn[nt], mn[nt]}; a = MFMA16(k0, qf[nt][0], a); a = MFMA16(k1, qf[nt][1], a); s[kt][nt] = a; }
            }
            if (own) {
                asm volatile("" ::: "memory");
#pragma unroll
                for (int nt = 0; nt < 2; ++nt) { const int qloc = 32 * wv + 16 * nt + fr - 128 * half - 4 * fq;
#pragma unroll
                    for (int kt = 0; kt < 8; ++kt)
#pragma unroll
                        for (int j = 0; j < 4; ++j) s[kt][nt][j] = (16 * kt + j <= qloc) ? s[kt][nt][j] : -INFINITY; }
            }
#pragma unroll
            for (int nt = 0; nt < 2; ++nt) {
                float ls = 0.f;
#pragma unroll
                for (int kt = 0; kt < 8; ++kt)
#pragma unroll
                    for (int j = 0; j < 4; ++j) { const float pv = __builtin_amdgcn_exp2f(s[kt][nt][j]); s[kt][nt][j] = pv; ls += pv; }
                lrun[nt] += ls;
            }
#pragma unroll
            for (int ks = 0; ks < 4; ++ks) {
                const bf16x8 pb0 = pack8(s[2 * ks][0], s[2 * ks + 1][0]), pb1 = pack8(s[2 * ks][1], s[2 * ks + 1][1]);
#pragma unroll
                for (int dt = 0; dt < 4; ++dt) { const bf16x8 vf = *(const LAS bf16x8*)(buf + KT_B + (16 * dt + fr) * 256 + (((4 * ks + fq) ^ fr) * 16));
                    oacc[dt][0] = MFMA16(vf, pb0, oacc[dt][0]); oacc[dt][1] = MFMA16(vf, pb1, oacc[dt][1]); }
            }
        }
        bcur = bcur == 2 ? 0 : bcur + 1;
    }
#undef ATT_DMA
    asm volatile("s_waitcnt vmcnt(0)" ::: "memory");
#pragma unroll
    for (int nt = 0; nt < 2; ++nt) {
        float lt = lrun[nt]; lt += __shfl_xor(lt, 16); lt += __shfl_xor(lt, 32); const float inv = 1.f / lt;
        bf16_t* dst = (dry ? (bf16_t*)(p.ws + WS_END) + (size_t)(32 * wv + 16 * nt + fr) * 1024 : O + (size_t)(t0 + 32 * wv + 16 * nt + fr) * 1024) + 512 + h * 64 + 4 * fq;
#pragma unroll
        for (int dt = 0; dt < 4; ++dt) { u32x2 w = {pk2(oacc[dt][nt][0] * inv, oacc[dt][nt][1] * inv), pk2(oacc[dt][nt][2] * inv, oacc[dt][nt][3] * inv)}; *(u32x2*)(dst + 16 * dt) = w; }
    }
    __syncthreads();
}

__device__ __forceinline__ void grid_barrier(unsigned* ctl, unsigned gen) {
    __syncthreads();
    if (threadIdx.x == 0) {
        __builtin_amdgcn_fence(__ATOMIC_RELEASE, "agent");
        const unsigned G = gridDim.x;
        if ((G & 7u) == 0u) {
            const unsigned gs = G >> 3, g = blockIdx.x & 7u;
            const unsigned old = __hip_atomic_fetch_add(ctl + 128 + 32 * g, 1u, __ATOMIC_RELAXED, __HIP_MEMORY_SCOPE_AGENT);
            if (old + 1u == gs * gen) {
                __builtin_amdgcn_fence(__ATOMIC_ACQ_REL, "agent");
                __hip_atomic_fetch_add(ctl + 64, 1u, __ATOMIC_RELAXED, __HIP_MEMORY_SCOPE_AGENT);
            }
            while (__hip_atomic_load(ctl + 64, __ATOMIC_RELAXED, __HIP_MEMORY_SCOPE_AGENT) < 8u * gen) __builtin_amdgcn_s_sleep(4);
        } else {
            __hip_atomic_fetch_add(ctl + 16, 1u, __ATOMIC_RELAXED, __HIP_MEMORY_SCOPE_AGENT);
            while (__hip_atomic_load(ctl + 16, __ATOMIC_RELAXED, __HIP_MEMORY_SCOPE_AGENT) < G * gen) __builtin_amdgcn_s_sleep(2);
        }
        __builtin_amdgcn_fence(__ATOMIC_ACQUIRE, "agent");
    }
    __syncthreads();
}
__device__ __forceinline__ void fill_row_scales(const pg8::StaticOrder& S, const float* ss, LAS float* rt) {
    const int tid = threadIdx.x;
    if (tid < 256) {
        float t[12];
#pragma unroll
        for (int i = 0; i < 12; ++i) { pg8::Unit u; t[i] = S.next(i, u) ? ss[u.pm * 256 + tid] : 1024.f; }
#pragma unroll
        for (int i = 0; i < 12; ++i) rt[i * 256 + tid] = rsqrtf(t[i] * (1.f / 1024.f) + EPS);
    }
    __syncthreads();
}
template <int PH>
__device__ __forceinline__ void run_phase(const Params& p, LAS unsigned char* lds) {
    unsigned char* ws = p.ws;
    if constexpr (PH == 0) { if constexpr (PH_MASK & 1) { phase_prep(p, lds); if constexpr (REP & 1) { __syncthreads(); phase_prep(p, lds); } } }
    else if constexpr (PH == 1 || PH == 7) {
        if constexpr (PH_MASK & 2) {
        pg8::Gemm g{(const bf16_t*)(ws + WS_X), (const bf16_t*)(ws + (PH == 1 ? WS_WGU1 : WS_WGU2)), T, 5632, 1024};
        pg8::StaticOrder S; S.init(g.M, g.N, (int)gridDim.x, (int)blockIdx.x);
        EpiSwiGLU<(PH == 7)> E{(bf16_t*)(ws + WS_R1), (const LAS float*)(lds + RT_OFF)};
        if constexpr (PH == 7) fill_row_scales(S, (const float*)(ws + WS_SS3), (LAS float*)(lds + RT_OFF));
        pg8::gemm_phase(lds, g, S, E);
        if constexpr ((REP & 2) && PH == 1) pg8::gemm_phase(lds, g, S, E); }
    } else if constexpr (PH == 2 || PH == 6 || PH == 8) {
        if constexpr (PH_MASK & 4) {
        bf16_t* xb = (bf16_t*)(ws + WS_X);
        if constexpr (PH == 2) { pg8::Gemm g{(const bf16_t*)(ws + WS_R1), (const bf16_t*)(ws + WS_WD1), T, 1024, FF}; EpiResid<0> E{p.in[I_X], nullptr, nullptr, xb, (float*)(ws + WS_SS2), 0.5f};
            pg8::StaticOrder S; S.init(g.M, g.N, (int)gridDim.x, (int)blockIdx.x); pg8::gemm_phase(lds, g, S, E);
            if constexpr (REP & 4) { E.ss = nullptr; pg8::gemm_phase(lds, g, S, E); } }
        else if constexpr (PH == 6) { pg8::Gemm g{(const bf16_t*)(ws + WS_O), (const bf16_t*)(ws + WS_WOUT), T, 1024, 1024}; EpiResid<1> E{nullptr, xb, nullptr, xb, (float*)(ws + WS_SS3), 1.0f};
            pg8::StaticOrder S; S.init(g.M, g.N, (int)gridDim.x, (int)blockIdx.x); pg8::gemm_phase(lds, g, S, E); }
        else { pg8::Gemm g{(const bf16_t*)(ws + WS_R1), (const bf16_t*)(ws + WS_WD2), T, 1024, FF}; EpiResid<2> E{nullptr, xb, p.out, nullptr, nullptr, 0.5f};
            pg8::StaticOrder S; S.init(g.M, g.N, (int)gridDim.x, (int)blockIdx.x); pg8::gemm_phase(lds, g, S, E); }
        }
    } else if constexpr (PH == 3) {
        if constexpr (PH_MASK & 8) {
        ab_rows(p);
        pg8::Gemm g{(const bf16_t*)(ws + WS_X), (const bf16_t*)(ws + WS_WIN), T, 3584, 1024};
        pg8::StaticOrder S; S.init(g.M, g.N, (int)gridDim.x, (int)blockIdx.x);
        EpiInProj E{(bf16_t*)(ws + WS_R1), (bf16_t*)(ws + WS_O), (const LAS float*)(lds + RT_OFF)};
        fill_row_scales(S, (const float*)(ws + WS_SS2), (LAS float*)(lds + RT_OFF));
        pg8::gemm_phase(lds, g, S, E);
        if constexpr (REP & 8) { ab_rows(p); pg8::gemm_phase(lds, g, S, E); } }
    } else if constexpr (PH == 4) {
        if constexpr (PH_MASK & 16) for (int rep = 0; rep < ((REP & 16) ? 2 : 1); ++rep) for (int it = blockIdx.x; it < 1024; it += gridDim.x) g1_item(p, lds, it);
        if constexpr (PH_MASK & 32) for (int rep = 0; rep < ((REP & 32) ? 2 : 1); ++rep) for (int it = blockIdx.x; it < 1024; it += gridDim.x) moba_prep_item(p, lds, it, (REP & 32) && rep == 0);
    } else if constexpr (PH == 5) {
        if constexpr (REP & 128) { LAS int* slot = (LAS int*)(lds + 119616); unsigned* ctr = (unsigned*)(ws + WS_CTR) + 1;
            for (;;) { if (threadIdx.x == 0) *slot = (int)atomicAdd(ctr, 1u); __syncthreads(); const int item = *slot; __syncthreads(); if (item >= 1024) break; moba_attn_item(p, lds, item, true); } }
        if constexpr (REP & 64) for (int bh = blockIdx.x; bh < 32; bh += gridDim.x) gdn_scan<(REP >> 8) & 7>(p, lds, bh);
        if constexpr (PH_MASK & 64) for (int bh = blockIdx.x; bh < 32; bh += gridDim.x) gdn_scan<0>(p, lds, bh);
        if constexpr (PH_MASK & 128) {
        LAS int* slot = (LAS int*)(lds + 119616);
        unsigned* ctr = (unsigned*)(ws + WS_CTR);
        const int nstat = (int)gridDim.x > 32 ? (int)gridDim.x - 32 : 0;
        bool first = (int)blockIdx.x >= 32;
        for (;;) {
            if (threadIdx.x == 0) *slot = first ? (int)blockIdx.x - 32 : nstat + (int)atomicAdd(ctr, 1u);
            first = false;
            __syncthreads();
            const int item = *slot;
            __syncthreads();
            if (item >= 1024) break;
            moba_attn_item(p, lds, item);
        } }
    }
}
__global__ void __launch_bounds__(512, 2) hymba_mega(Params p) {
    extern __shared__ __attribute__((aligned(16))) unsigned char shm[];
    LAS unsigned char* lds = (LAS unsigned char*)shm;
    cg::grid_group grid = cg::this_grid();
    const int lo = p.ph_lo, hi = p.ph_hi;
    unsigned* bar = (unsigned*)(p.ws + WS_CTR);
    if (hi > 1000) grid.sync();
#define RUN_PH(k) do { if (lo <= (k) && (k) < hi) { run_phase<k>(p, lds); if ((k) + 1 < hi) grid_barrier(bar, (unsigned)((k) + 1 - lo)); } } while (0)
    RUN_PH(0); RUN_PH(1); RUN_PH(2); RUN_PH(3); RUN_PH(4); RUN_PH(5); RUN_PH(6); RUN_PH(7); RUN_PH(8);
#undef RUN_PH
}

extern "C" void kernel_launch(void* const* d_in, const int* in_sizes, int n_in, void* d_out, int out_size, void* d_ws, size_t ws_size, hipStream_t stream) {
    static int grid_blocks = 0;
    if (grid_blocks == 0) {
        if (n_in != 18 || in_sizes[0] != T * DM || out_size != T * DM || ws_size < WS_END) {
            fprintf(stderr, "kernel_launch: unexpected shapes (n_in %d, in0 %d, out %d, ws %zu, need %zu)\n", n_in, n_in > 0 ? in_sizes[0] : -1, out_size, ws_size, (size_t)WS_END);
            grid_blocks = -1; return; }
        int dev = 0, cus = 0, per_cu = 0;
        hipGetDevice(&dev);
        hipDeviceGetAttribute(&cus, hipDeviceAttributeMultiprocessorCount, dev);
        if (hipFuncSetAttribute((const void*)hymba_mega, hipFuncAttributeMaxDynamicSharedMemorySize, LDS_BYTES) != hipSuccess) { fprintf(stderr, "kernel_launch: hipFuncSetAttribute failed\n"); grid_blocks = -1; return; }
        if (hipOccupancyMaxActiveBlocksPerMultiprocessor(&per_cu, (const void*)hymba_mega, 512, LDS_BYTES) != hipSuccess || per_cu < 1) { fprintf(stderr, "kernel_launch: occupancy query says %d\n", per_cu); (void)hipGetLastError(); per_cu = 1; }
        grid_blocks = cus * (per_cu > 1 ? 1 : per_cu);
        if (grid_blocks < 1) grid_blocks = 256;
    }
    if (grid_blocks < 0) return;
    if (hipMemsetAsync((char*)d_ws + WS_CTR, 0, 4096, stream) != hipSuccess) { fprintf(stderr, "kernel_launch: hipMemsetAsync failed\n"); return; }
    Params p{};
    for (int i = 0; i < 18; ++i) p.in[i] = (const float*)d_in[i];
    p.out = (float*)d_out; p.ws = (unsigned char*)d_ws;
#if N_LAUNCH_MODE == 1
    p.ph_lo = 0; p.ph_hi = 9;
    void* args[] = {&p};
    hipError_t e = hipLaunchCooperativeKernel((const void*)hymba_mega, dim3(grid_blocks), dim3(512), args, LDS_BYTES, stream);
    if (e != hipSuccess) fprintf(stderr, "cooperative launch failed: %s (grid %d)\n", hipGetErrorString(e), grid_blocks);
#else
    for (int ph = 0; ph < 9; ++ph) { p.ph_lo = ph; p.ph_hi = ph + 1; hipLaunchKernelGGL(hymba_mega, dim3(grid_blocks), dim3(512), LDS_BYTES, stream, p); }
#endif
}
```
